# Optimizing an MI355X kernel written in HIP

```python
import jax
import jax.numpy as jnp
from jax import lax
import numpy as np

D_MODEL = 1024
BATCH = 4
SEQ = 4096
DEPTH = 4

CTX_LEN = 256
GRID_W = 64
GLA_HEADS = 4
GLA_DK = 128
GLA_DV = 256
GLA_RANK = 16
GLA_TAU = 16.0
GLA_CHUNK = 64
NAT_HEADS = 8
NAT_DH = 64
WIN_H = 8
WIN_W = 16
NAT_QB = 16
NAT_BAND = NAT_QB + WIN_W
D_FF = 3584
N_EXPERTS = 8
TOP_K = 2
ROPE_BASE = 10000.0
EPS = 1e-6
GLA_QK = GLA_HEADS * GLA_DK
GLA_V = GLA_HEADS * GLA_DV
NAT_W = NAT_HEADS * NAT_DH
SPLITS = (GLA_QK, GLA_QK, GLA_V, GLA_V, GLA_RANK, GLA_RANK, NAT_W, NAT_W, NAT_W, D_MODEL, D_MODEL)
D_IN = sum(SPLITS)
N_DENSE = (DEPTH + 1) // 2
N_MOE = DEPTH // 2

kernel_name = 'hybrid_gla_natten_moe_dit_trunk'


def _rmsnorm(x, g):
    xf = x.astype(jnp.float32)
    y = xf * lax.rsqrt(jnp.mean(xf * xf, axis=-1, keepdims=True) + EPS)
    return (y * g.astype(jnp.float32)).astype(x.dtype)


def _modulate(x, shift, scale):
    return x * (1.0 + scale[:, None, :]) + shift[:, None, :]


def _heads(x, n_heads):
    b, t, w = x.shape
    return x.reshape(b, t, n_heads, w // n_heads).transpose(0, 2, 1, 3)


def _merge_heads(x):
    b, h, t, d = x.shape
    return x.transpose(0, 2, 1, 3).reshape(b, t, h * d)


def _axial_rope(x, row_pos, col_pos):
    half = x.shape[-1] // 2
    nf = half // 2
    inv = ROPE_BASE ** (-jnp.arange(nf, dtype=jnp.float32) / nf)

    def rot(xp, pos):
        ang = pos.astype(jnp.float32)[:, None] * inv[None, :]
        cos, sin = jnp.cos(ang), jnp.sin(ang)
        x1, x2 = xp[..., :nf], xp[..., nf:]
        return jnp.concatenate([x1 * cos - x2 * sin, x1 * sin + x2 * cos], axis=-1)

    return jnp.concatenate([rot(x[..., :half], row_pos), rot(x[..., half:], col_pos)], axis=-1).astype(x.dtype)


def _gla_log_gate(a, w2, b):
    z = jnp.einsum('btr,rk->btk', a.astype(jnp.float32), w2.astype(jnp.float32)) + b.astype(jnp.float32)
    return _heads(jax.nn.log_sigmoid(z) / GLA_TAU, GLA_HEADS)


def _gla_scan(q, k, v, lg, s0):
    bsz, h, t, dk = q.shape
    dv = v.shape[-1]
    n = t // GLA_CHUNK
    f32 = jnp.float32
    q = q.astype(f32).reshape(bsz, h, n, GLA_CHUNK, dk)
    k = k.astype(f32).reshape(bsz, h, n, GLA_CHUNK, dk)
    v = v.astype(f32).reshape(bsz, h, n, GLA_CHUNK, dv)
    b = jnp.cumsum(lg.reshape(bsz, h, n, GLA_CHUNK, dk), axis=3)
    b_last = b[:, :, :, -1:, :]
    q_e = q * jnp.exp(b)
    k_e = k * jnp.exp(-b)
    k_d = k * jnp.exp(b_last - b)
    tri = np.tril(np.ones((GLA_CHUNK, GLA_CHUNK), dtype=bool))
    a = jnp.where(tri, jnp.einsum('bhncd,bhnsd->bhncs', q_e, k_e), 0.0)
    o_intra = jnp.einsum('bhncs,bhnsv->bhncv', a, v)
    decay = jnp.exp(b_last[:, :, :, 0, :])

    def step(state, xs):
        qe, kd, vv, dec = xs
        o = jnp.einsum('bhcd,bhdv->bhcv', qe, state)
        state = dec[..., None] * state + jnp.einsum('bhcd,bhcv->bhdv', kd, vv)
        return state, o

    mv = lambda arr: jnp.moveaxis(arr, 2, 0)
    s_fin, o_inter = lax.scan(step, s0.astype(f32), (mv(q_e), mv(k_d), mv(v), mv(decay)))
    o = o_intra + jnp.moveaxis(o_inter, 0, 2)
    return o.reshape(bsz, h, t, dv), s_fin


def _gla_bidir(q, k, v, lg_f, lg_b, s0_f, s0_b):
    o_f, s_f = _gla_scan(q, k, v, lg_f, s0_f)
    rev = lambda arr: jnp.flip(arr, axis=2)
    o_b, s_b = _gla_scan(rev(q), rev(k), rev(v), rev(lg_b), s0_b)
    return o_f + rev(o_b), s_f, s_b


def _gla_out(o, r, gain):
    on = o * lax.rsqrt(jnp.mean(o * o, axis=-1, keepdims=True) + EPS)
    return (_merge_heads(on) * gain.astype(jnp.float32)).astype(r.dtype) * jax.nn.silu(r)


def _natten_latent(q, k, v, k_ctx, v_ctx, rpb):
    bsz, h, s, d = q.shape
    rows = s // GRID_W
    kh = min(WIN_H, rows)
    nb = GRID_W // NAT_QB
    scale = d ** -0.5
    r = np.arange(rows)
    row_start = np.clip(r - kh // 2, 0, rows - kh)
    row_off = row_start[:, None] + np.arange(kh)[None, :] - r[:, None] + (WIN_H - 1)
    qcol = np.arange(GRID_W).reshape(nb, NAT_QB)
    col_start = np.clip(qcol - WIN_W // 2, 0, GRID_W - WIN_W)
    band_start = np.clip(np.arange(nb) * NAT_QB - WIN_W // 2, 0, GRID_W - NAT_BAND)
    kcol = band_start[:, None] + np.arange(NAT_BAND)[None, :]
    col_in = (kcol[:, None, :] >= col_start[:, :, None]) & (kcol[:, None, :] < col_start[:, :, None] + WIN_W)
    col_off = np.clip(kcol[:, None, :] - qcol[:, :, None], 1 - WIN_W, WIN_W - 1) + (WIN_W - 1)
    bias = rpb.astype(jnp.float32)[:, row_off][..., col_off]
    bias = jnp.where(col_in[:, :, None, :], bias.transpose(1, 0, 3, 4, 2, 5), -jnp.inf)
    kb = k.reshape(bsz, h, rows, GRID_W, d)[:, :, :, kcol]
    vb = v.reshape(bsz, h, rows, GRID_W, d)[:, :, :, kcol]
    qr = q.reshape(bsz, h, rows, nb, NAT_QB, d).transpose(2, 0, 1, 3, 4, 5)
    n_lat = kh * NAT_BAND

    def one_row(args):
        q_r, rs, bias_r = args
        k_r = lax.dynamic_slice_in_dim(kb, rs, kh, axis=2)
        v_r = lax.dynamic_slice_in_dim(vb, rs, kh, axis=2)
        s_lat = jnp.einsum('bhnqd,bhknjd->bhnqkj', q_r, k_r).astype(jnp.float32) * scale + bias_r
        s_ctx = jnp.einsum('bhnqd,bhld->bhnql', q_r, k_ctx).astype(jnp.float32) * scale
        sc = jnp.concatenate([s_lat.reshape(bsz, h, nb, NAT_QB, n_lat), s_ctx], axis=-1)
        p = jax.nn.softmax(sc, axis=-1).astype(v.dtype)
        p_lat = p[..., :n_lat].reshape(bsz, h, nb, NAT_QB, kh, NAT_BAND)
        return (jnp.einsum('bhnqkj,bhknjd->bhnqd', p_lat, v_r)
                + jnp.einsum('bhnql,bhld->bhnqd', p[..., n_lat:], v_ctx))

    out = lax.map(one_row, (qr, jnp.asarray(row_start, jnp.int32), bias))
    return out.transpose(1, 2, 0, 3, 4, 5).reshape(bsz, h, s, d)


def _ctx_attn(q, k, v):
    s = jnp.einsum('bhld,bhmd->bhlm', q, k).astype(jnp.float32) * (q.shape[-1] ** -0.5)
    p = jax.nn.softmax(s, axis=-1).astype(v.dtype)
    return jnp.einsum('bhlm,bhmd->bhld', p, v)


def _merge_branches(y_gla, y_nat, ga, gb, w_bg, w_bn, w_o):
    m = jax.nn.sigmoid(ga) * (y_gla @ w_bg) + jax.nn.sigmoid(gb) * (y_nat @ w_bn)
    return m @ w_o


def _token_mixer(h_c, h_l, w_in, gate_w2, gate_b, gla_g, rpb, w_bg, w_bn, w_o, need_ctx):
    bsz, s, _ = h_l.shape
    idx = np.cumsum(SPLITS)[:-1].tolist()
    gq_c, gk_c, gv_c, gr_c, af_c, ab_c, nq_c, nk_c, nv_c, ga_c, gb_c = jnp.split(h_c @ w_in, idx, axis=-1)
    gq_l, gk_l, gv_l, gr_l, af_l, ab_l, nq_l, nk_l, nv_l, ga_l, gb_l = jnp.split(h_l @ w_in, idx, axis=-1)
    t = jnp.arange(s, dtype=jnp.int32)
    row_pos, col_pos = t // GRID_W, t % GRID_W
    qscale = GLA_DK ** -0.5
    zero = jnp.zeros((bsz, GLA_HEADS, GLA_DK, GLA_DV), jnp.float32)
    o_gc, s_f, s_b = _gla_bidir(_heads(gq_c, GLA_HEADS) * qscale, _heads(gk_c, GLA_HEADS), _heads(gv_c, GLA_HEADS),
                                _gla_log_gate(af_c, gate_w2[0], gate_b[0]), _gla_log_gate(ab_c, gate_w2[1], gate_b[1]),
                                zero, zero)
    q_l = _axial_rope(_heads(gq_l, GLA_HEADS), row_pos, col_pos) * qscale
    k_l = _axial_rope(_heads(gk_l, GLA_HEADS), row_pos, col_pos)
    o_gl, _, _ = _gla_bidir(q_l, k_l, _heads(gv_l, GLA_HEADS),
                            _gla_log_gate(af_l, gate_w2[0], gate_b[0]), _gla_log_gate(ab_l, gate_w2[1], gate_b[1]),
                            s_f, s_b)
    nk_ch, nv_ch = _heads(nk_c, NAT_HEADS), _heads(nv_c, NAT_HEADS)
    o_nl = _natten_latent(_heads(nq_l, NAT_HEADS), _heads(nk_l, NAT_HEADS), _heads(nv_l, NAT_HEADS), nk_ch, nv_ch, rpb)
    y_l = _merge_branches(_gla_out(o_gl, gr_l, gla_g), _merge_heads(o_nl), ga_l, gb_l, w_bg, w_bn, w_o)
    if not need_ctx:
        return y_l, None
    o_nc = _ctx_attn(_heads(nq_c, NAT_HEADS), nk_ch, nv_ch)
    y_c = _merge_branches(_gla_out(o_gc, gr_c, gla_g), _merge_heads(o_nc), ga_c, gb_c, w_bg, w_bn, w_o)
    return y_l, y_c


def _swiglu(x, w1, w3, w2):
    return (jax.nn.silu(x @ w1) * (x @ w3)) @ w2


def _moe(x, w_r, w1, w3, w2):
    logits = jnp.einsum('btd,de->bte', x, w_r).astype(jnp.float32)
    top_v, top_i = lax.top_k(logits, TOP_K)
    wts = jax.nn.softmax(top_v, axis=-1)
    gates = jnp.sum(jax.nn.one_hot(top_i, N_EXPERTS, dtype=jnp.float32) * wts[..., None], axis=-2)
    y = jnp.zeros_like(x)
    for e in range(N_EXPERTS):
        y = y + gates[..., e:e + 1].astype(x.dtype) * _swiglu(x, w1[e], w3[e], w2[e])
    return y


def _channel_mixer(h, i, ffn_w1, ffn_w3, ffn_w2, moe_router, moe_w1, moe_w3, moe_w2):
    j = i // 2
    if i % 2 == 0:
        return _swiglu(h, ffn_w1[j], ffn_w3[j], ffn_w2[j])
    return _moe(h, moe_router[j], moe_w1[j], moe_w3[j], moe_w2[j])


def setup_inputs(seed: int = 0) -> dict:
    key = jax.random.key(seed)
    ks = jax.random.split(key, 32)
    D = D_MODEL

    def nrm(k, shape, s):
        return jax.random.normal(k, shape, jnp.float32) * s

    return {
        'x': nrm(ks[0], (BATCH, SEQ, D), 1.0),
        'c': nrm(ks[1], (BATCH, D), 1.0),
        'ctx': nrm(ks[2], (BATCH, CTX_LEN, D), 1.0),
        'c_ctx': nrm(ks[3], (D,), 1.0),
        'w_mod': nrm(ks[4], (DEPTH, D, 6 * D), 0.5 * D ** -0.5),
        'b_mod': nrm(ks[5], (DEPTH, 6 * D), 0.01),
        'norm_mix_pre': 1.0 + nrm(ks[6], (DEPTH, D), 0.02),
        'norm_mix_post': 1.0 + nrm(ks[7], (DEPTH, D), 0.02),
        'w_in': nrm(ks[8], (DEPTH, D, D_IN), D ** -0.5),
        'gla_gate_w2': nrm(ks[9], (DEPTH, 2, GLA_RANK, GLA_QK), GLA_RANK ** -0.5),
        'gla_gate_b': nrm(ks[10], (DEPTH, 2, GLA_QK), 0.1),
        'gla_norm': 1.0 + nrm(ks[11], (DEPTH, GLA_V), 0.02),
        'nat_rpb': nrm(ks[12], (DEPTH, NAT_HEADS, 2 * WIN_H - 1, 2 * WIN_W - 1), 0.02),
        'w_branch_gla': nrm(ks[13], (DEPTH, GLA_V, D), GLA_V ** -0.5),
        'w_branch_nat': nrm(ks[14], (DEPTH, NAT_W, D), NAT_W ** -0.5),
        'w_out': nrm(ks[15], (DEPTH, D, D), D ** -0.5),
        'norm_ffn_pre': 1.0 + nrm(ks[16], (DEPTH, D), 0.02),
        'norm_ffn_post': 1.0 + nrm(ks[17], (DEPTH, D), 0.02),
        'ffn_w1': nrm(ks[18], (N_DENSE, D, D_FF), D ** -0.5),
        'ffn_w3': nrm(ks[19], (N_DENSE, D, D_FF), D ** -0.5),
        'ffn_w2': nrm(ks[20], (N_DENSE, D_FF, D), D_FF ** -0.5),
        'moe_router': nrm(ks[21], (N_MOE, D, N_EXPERTS), D ** -0.5),
        'moe_w1': nrm(ks[22], (N_MOE, N_EXPERTS, D, D_FF), D ** -0.5),
        'moe_w3': nrm(ks[23], (N_MOE, N_EXPERTS, D, D_FF), D ** -0.5),
        'moe_w2': nrm(ks[24], (N_MOE, N_EXPERTS, D_FF, D), D_FF ** -0.5),
    }


def reference(x, c, ctx, c_ctx, w_mod, b_mod, norm_mix_pre, norm_mix_post, w_in, gla_gate_w2, gla_gate_b,
              gla_norm, nat_rpb, w_branch_gla, w_branch_nat, w_out, norm_ffn_pre, norm_ffn_post,
              ffn_w1, ffn_w3, ffn_w2, moe_router, moe_w1, moe_w3, moe_w2):
    x_l, x_c = x, ctx
    s_lat = jax.nn.silu(c)
    s_ctx = jax.nn.silu(c_ctx)[None]
    for i in range(DEPTH):
        need_ctx = i < DEPTH - 1
        m_l = jnp.split(s_lat @ w_mod[i] + b_mod[i], 6, axis=-1)
        m_c = jnp.split(s_ctx @ w_mod[i] + b_mod[i], 6, axis=-1)
        h_l = _modulate(_rmsnorm(x_l, norm_mix_pre[i]), m_l[0], m_l[1])
        h_c = _modulate(_rmsnorm(x_c, norm_mix_pre[i]), m_c[0], m_c[1])
        y_l, y_c = _token_mixer(h_c, h_l, w_in[i], gla_gate_w2[i], gla_gate_b[i], gla_norm[i], nat_rpb[i],
                                w_branch_gla[i], w_branch_nat[i], w_out[i], need_ctx)
        x_l = x_l + m_l[2][:, None, :] * _rmsnorm(y_l, norm_mix_post[i])
        f_l = _channel_mixer(_modulate(_rmsnorm(x_l, norm_ffn_pre[i]), m_l[3], m_l[4]), i,
                             ffn_w1, ffn_w3, ffn_w2, moe_router, moe_w1, moe_w3, moe_w2)
        x_l = x_l + m_l[5][:, None, :] * _rmsnorm(f_l, norm_ffn_post[i])
        if need_ctx:
            x_c = x_c + m_c[2][:, None, :] * _rmsnorm(y_c, norm_mix_post[i])
            f_c = _channel_mixer(_modulate(_rmsnorm(x_c, norm_ffn_pre[i]), m_c[3], m_c[4]), i,
                                 ffn_w1, ffn_w3, ffn_w2, moe_router, moe_w1, moe_w3, moe_w2)
            x_c = x_c + m_c[5][:, None, :] * _rmsnorm(f_c, norm_ffn_post[i])
    return x_l
```

```cpp
#include <hip/hip_runtime.h>
#include <cstdio>
#include <cstdint>
namespace pg8 {
#define PG8_LAS __attribute__((address_space(3)))
typedef unsigned short bf16_t;
typedef short bf16x8 __attribute__((ext_vector_type(8)));
typedef float f32x4 __attribute__((ext_vector_type(4)));
typedef unsigned u32x4 __attribute__((ext_vector_type(4)));
typedef int v8i_t __attribute__((ext_vector_type(8)));
constexpr int BM = 256, BK = 64, HALF = 128, HTB = HALF * BK * 2  , STAGE_BYTES = 8 * HTB, NXCD = 8, WGM = 4;

__host__ __device__ __forceinline__ int lds_byte(int r, int c) { const int st = (r >> 4) * 2 + (c >> 5), rr = r & 15, cc = c & 31, ob = rr * 64 + cc * 2; return st * 1024 + (ob ^ (((ob >> 9) & 1) << 5)); }
__host__ __device__ __forceinline__ void stage_rc(int b, int& R, int& C) { const int st = b / 1024, sb = b % 1024, swz = sb ^ (((sb >> 9) & 1) << 5); R = (st >> 1) * 16 + swz / 64; C = (st & 1) * 32 + (swz % 64) / 2; }
__host__ __device__ __forceinline__ int perm32(int rho) { const int n = rho >> 4, i = rho & 15; return 8 * (i >> 2) + 4 * n + (i & 3); }

struct Unit { int pm, pn; long boff; long koff; int nt; };
struct Gemm { const bf16_t* A; const bf16_t* Bt; int M, N, K; };

struct StaticOrder {
    int nM, nN, nwg, G, c;
    __host__ __device__ void init(int M, int N, int G_, int c_) { nM = M / BM; nN = N / BM; nwg = nM * nN; G = G_; c = c_; }
    __host__ __device__ bool next(int i, Unit& u) const {
        const long L = (long)i * G + c; if (L >= nwg) return false;
        int wgid = (int)L; { const int q = nwg / NXCD, r = nwg % NXCD, xcd = wgid % NXCD, off = wgid / NXCD; wgid = (xcd < r ? xcd * (q + 1) : r * (q + 1) + (xcd - r) * q) + off; }
        const int nig = WGM * nN, gid = wgid / nig, fm = gid * WGM, gsz = (nM - fm) < WGM ? (nM - fm) : WGM;
        u.pm = fm + ((wgid % nig) % gsz); u.pn = (wgid % nig) / gsz; u.boff = 0; u.koff = 0; u.nt = 0; return true;
    }
    __device__ __forceinline__ void a_ready(const Unit&) const {}
    __device__ __forceinline__ void done(const Unit&) const {}
};

typedef __bf16 bf16x2_t __attribute__((ext_vector_type(2)));
typedef float f32x2_t __attribute__((ext_vector_type(2)));
__device__ __forceinline__ unsigned cvt_pk_bf16(float lo, float hi) { const f32x2_t v = {lo, hi}; const bf16x2_t b = __builtin_convertvector(v, bf16x2_t); return __builtin_bit_cast(unsigned, b); }
typedef float f32x2 __attribute__((ext_vector_type(2)));
__device__ __forceinline__ f32x2 gelu_pk(f32x2 v) {
    const f32x2 av = __builtin_elementwise_abs(v), d = av * 0.2316418882f + 1.0f;
    f32x2 t; t.x = __builtin_amdgcn_rcpf(d.x); t.y = __builtin_amdgcn_rcpf(d.y);
    f32x2 q = t * 0.5307027145f + (-0.7265760135f); q = q * t + 0.7107068705f; q = q * t + (-0.142248368f); q = q * t + 0.127414796f; q = q * t;
    const f32x2 s = (v * v) * (-0.72134752044f);
    f32x2 e; e.x = __builtin_amdgcn_exp2f(s.x); e.y = __builtin_amdgcn_exp2f(s.y);
    const f32x2 m = v * (q * e), r = v - m;
    f32x2 o; o.x = v.x < 0.f ? m.x : r.x; o.y = v.y < 0.f ? m.y : r.y; return o;
}

__device__ __forceinline__ float bflo(unsigned w) { return __uint_as_float(w << 16); }
__device__ __forceinline__ float bfhi(unsigned w) { return __uint_as_float(w & 0xffff0000u); }
__device__ __forceinline__ float sigmoidf_(float x) { return __builtin_amdgcn_rcpf(1.0f + __expf(-x)); }
__device__ __forceinline__ unsigned pk4_fp8(float a, float b, float c, float d) {
    a = __builtin_amdgcn_fmed3f(a, -448.f, 448.f); b = __builtin_amdgcn_fmed3f(b, -448.f, 448.f); c = __builtin_amdgcn_fmed3f(c, -448.f, 448.f); d = __builtin_amdgcn_fmed3f(d, -448.f, 448.f);
    int w = 0; w = __builtin_amdgcn_cvt_pk_fp8_f32(a, b, w, false); w = __builtin_amdgcn_cvt_pk_fp8_f32(c, d, w, true); return (unsigned)w;
}
struct EpiStore {
    static constexpr bool PERM = true, AFTER_DRAIN = false;
    bf16_t* O; int ldc; int mrows;
    __device__ __forceinline__ void operator()(const f32x4 (&acc)[2][2][4][2], const Unit& u, int wr, int wc, int fr, int fq) const {
        const int row0 = u.pm * BM + wr * 64 + fr, col0 = u.pn * BM + wc * 32 + 8 * fq;
#pragma unroll
        for (int ai = 0; ai < 2; ++ai)
#pragma unroll
            for (int m = 0; m < 4; ++m) { const int row = row0 + ai * HALF + m * 16; if (row >= mrows) continue; bf16_t* rowp = O + (size_t)row * ldc + col0;
#pragma unroll
                for (int bj = 0; bj < 2; ++bj) { const f32x4 v0 = acc[ai][bj][m][0], v1 = acc[ai][bj][m][1];
                    u32x4 w; w.x = cvt_pk_bf16(v0[0], v0[1]); w.y = cvt_pk_bf16(v0[2], v0[3]); w.z = cvt_pk_bf16(v1[0], v1[1]); w.w = cvt_pk_bf16(v1[2], v1[3]);
                    *(u32x4*)(rowp + bj * HALF) = w; } }
    }
};
template <bool ACCUM> struct EpiGate {
    static constexpr bool PERM = true, AFTER_DRAIN = false;
    bf16_t* O; int ldc; const bf16_t* G; int ldg;
    __device__ __forceinline__ void operator()(const f32x4 (&acc)[2][2][4][2], const Unit& u, int wr, int wc, int fr, int fq) const {
        const int row0 = u.pm * BM + wr * 64 + fr, col0 = u.pn * BM + wc * 32 + 8 * fq;
#pragma unroll
        for (int ai = 0; ai < 2; ++ai)
#pragma unroll
            for (int m = 0; m < 4; ++m) { const int row = row0 + ai * HALF + m * 16; bf16_t* rowp = O + (size_t)row * ldc + col0; const bf16_t* gp = G + (size_t)row * ldg + col0;
#pragma unroll
                for (int bj = 0; bj < 2; ++bj) { const f32x4 v0 = acc[ai][bj][m][0], v1 = acc[ai][bj][m][1];
                    const u32x4 g = *(const u32x4*)(gp + bj * HALF);
                    float r[8];
                    r[0] = sigmoidf_(bflo(g.x)) * v0[0]; r[1] = sigmoidf_(bfhi(g.x)) * v0[1]; r[2] = sigmoidf_(bflo(g.y)) * v0[2]; r[3] = sigmoidf_(bfhi(g.y)) * v0[3];
                    r[4] = sigmoidf_(bflo(g.z)) * v1[0]; r[5] = sigmoidf_(bfhi(g.z)) * v1[1]; r[6] = sigmoidf_(bflo(g.w)) * v1[2]; r[7] = sigmoidf_(bfhi(g.w)) * v1[3];
                    if (ACCUM) { const u32x4 o = *(const u32x4*)(rowp + bj * HALF);
                        r[0] += bflo(o.x); r[1] += bfhi(o.x); r[2] += bflo(o.y); r[3] += bfhi(o.y); r[4] += bflo(o.z); r[5] += bfhi(o.z); r[6] += bflo(o.w); r[7] += bfhi(o.w); }
                    u32x4 w; w.x = cvt_pk_bf16(r[0], r[1]); w.y = cvt_pk_bf16(r[2], r[3]); w.z = cvt_pk_bf16(r[4], r[5]); w.w = cvt_pk_bf16(r[6], r[7]);
                    *(u32x4*)(rowp + bj * HALF) = w; }
                asm volatile("" ::: "memory"); }
    }
};
struct EpiSwiGLU {
    static constexpr bool PERM = true, AFTER_DRAIN = false;
    bf16_t* O; int ldc;
    __device__ __forceinline__ void operator()(const f32x4 (&acc)[2][2][4][2], const Unit& u, int wr, int wc, int fr, int fq) const {
        const int row0 = u.pm * BM + wr * 64 + fr, col0 = u.pn * HALF + wc * 32 + 8 * fq;
#pragma unroll
        for (int ai = 0; ai < 2; ++ai)
#pragma unroll
            for (int m = 0; m < 4; ++m) { bf16_t* rowp = O + (size_t)(row0 + ai * HALF + m * 16) * ldc + col0;
                float r[8];
#pragma unroll
                for (int n = 0; n < 2; ++n)
#pragma unroll
                    for (int j = 0; j < 4; ++j) { const float g = acc[ai][0][m][n][j], up = acc[ai][1][m][n][j]; r[4 * n + j] = g * sigmoidf_(g) * up; }
                u32x4 w; w.x = cvt_pk_bf16(r[0], r[1]); w.y = cvt_pk_bf16(r[2], r[3]); w.z = cvt_pk_bf16(r[4], r[5]); w.w = cvt_pk_bf16(r[6], r[7]);
                *(u32x4*)rowp = w; }
    }
};
struct EpiSwiGLU8 {
    static constexpr bool PERM = true, AFTER_DRAIN = false;
    unsigned char* O; int ldc;
    __device__ __forceinline__ void operator()(const f32x4 (&acc)[2][2][4][2], const Unit& u, int wr, int wc, int fr, int fq) const {
        const int row0 = u.pm * BM + wr * 64 + fr, col0 = u.pn * HALF + wc * 32 + 8 * fq;
#pragma unroll
        for (int ai = 0; ai < 2; ++ai)
#pragma unroll
            for (int m = 0; m < 4; ++m) { unsigned char* rowp = O + (size_t)(row0 + ai * HALF + m * 16) * ldc + col0;
                float r[8];
#pragma unroll
                for (int n = 0; n < 2; ++n)
#pragma unroll
                    for (int j = 0; j < 4; ++j) { const float g = acc[ai][0][m][n][j], up = acc[ai][1][m][n][j]; r[4 * n + j] = g * sigmoidf_(g) * up; }
                typedef unsigned u32x2_ __attribute__((ext_vector_type(2)));
                u32x2_ w; w.x = pk4_fp8(r[0], r[1], r[2], r[3]); w.y = pk4_fp8(r[4], r[5], r[6], r[7]);
                *(u32x2_*)rowp = w; }
    }
};
struct EpiAccF32 {
    static constexpr bool PERM = false, AFTER_DRAIN = false;
    float* O; int ldc; const float* gate; int gstride; int first;
    __device__ __forceinline__ void operator()(const f32x4 (&acc)[2][2][4][2], const Unit& u, int wr, int wc, int fr, int fq) const {
        const int row0 = u.pm * BM + wr * 64 + fr, col0 = u.pn * BM + wc * 32 + 4 * fq;
#pragma unroll
        for (int ai = 0; ai < 2; ++ai)
#pragma unroll
            for (int m = 0; m < 4; ++m) { const int row = row0 + ai * HALF + m * 16; float* rowp = O + (size_t)row * ldc + col0; const float gt = gate ? gate[(size_t)row * gstride] : 1.0f;
#pragma unroll
                for (int bj = 0; bj < 2; ++bj)
#pragma unroll
                    for (int n = 0; n < 2; ++n) { f32x4 v = acc[ai][bj][m][n] * gt; float* p = rowp + bj * HALF + n * 16; if (!first) v += *(const f32x4*)p; *(f32x4*)p = v; }
                asm volatile("" ::: "memory"); }
    }
};

struct MoeOrder {
    int nM, nN, nwg, G, c; int tstart[9]; long bstride;
    int nMn, KS, slice, nwn;
    __device__ __forceinline__ void init(const int (&cnt)[8], int nN_, long bstride_, int G_, int c_, int nMn_ = -1, int KS_ = 1, int slice_ = 0) {
        tstart[0] = 0;
#pragma unroll
        for (int x = 0; x < 8; ++x) tstart[x + 1] = tstart[x] + ((cnt[x] + 255) >> 8);
        nM = tstart[8]; nN = nN_; G = G_; c = c_; bstride = bstride_;
        nMn = nMn_ < 0 ? nM : nMn_; KS = KS_; slice = slice_; nwn = nMn * nN; nwg = nwn + (nM - nMn) * nN * KS;
    }
    __device__ __forceinline__ bool next(int i, Unit& u) const {
        const long L = (long)i * G + c; if (L >= nwg) return false;
        if (L < nwn) {
            int wgid = (int)L; { const int q = nwn / NXCD, r = nwn % NXCD, xcd = wgid % NXCD, off = wgid / NXCD; wgid = (xcd < r ? xcd * (q + 1) : r * (q + 1) + (xcd - r) * q) + off; }
            const int nig = WGM * nN, gid = wgid / nig, fm = gid * WGM, gsz = (nMn - fm) < WGM ? (nMn - fm) : WGM;
            u.pm = fm + ((wgid % nig) % gsz); u.pn = (wgid % nig) / gsz; u.koff = 0; u.nt = 0;
        } else { const int j = (int)L - nwn; u.pm = nMn + j / (nN * KS); u.pn = (j / KS) % nN; u.koff = (long)(j % KS) * slice * 2; u.nt = slice >> 6; }
        int x = 0;
#pragma unroll
        for (int k = 1; k < 8; ++k) x += (u.pm >= tstart[k]) ? 1 : 0;
        u.boff = (long)x * bstride; return true;
    }
    __device__ __forceinline__ void a_ready(const Unit&) const {}
    __device__ __forceinline__ void done(const Unit&) const {}
};

struct CtxSplitOrder {
    StaticOrder lat; int KS, nctx, G, c, slice;
    __device__ __forceinline__ void init(int Mlat, int K, int slice_, int G_, int c_) { lat.init(Mlat, 1024, G_, c_); slice = slice_; KS = K / slice_; nctx = 16 * KS; G = G_; c = c_; }
    __device__ __forceinline__ bool next(int i, Unit& u) const {
        if (lat.next(i, u)) return true;
        const int j = i * G + c - lat.nwg;
        if (j >= nctx) return false;
        u.pm = 64 + j / (4 * KS); u.pn = (j / KS) & 3; u.boff = 0; u.koff = (long)(j % KS) * slice * 2; u.nt = slice >> 6; return true;
    }
    __device__ __forceinline__ void a_ready(const Unit&) const {}
    __device__ __forceinline__ void done(const Unit&) const {}
};
struct BranchOrder {
    StaticOrder lat; int G, c, first, nsub, KH, kslice;
    __device__ __forceinline__ void init(int Mlat, int G_, int c_, int first_, int nsub_, int KH_, int kslice_) { lat.init(Mlat, 1024, G_, c_); G = G_; c = c_; first = first_; nsub = nsub_; KH = KH_; kslice = kslice_; }
    __device__ __forceinline__ bool next(int i, Unit& u) const {
        if (lat.next(i, u)) return true;
        const int j = i * G + c - lat.nwg - first;
        if (j < 0 || j >= nsub) return false;
        const int tile = j / KH, hf = j % KH;
        u.pm = 64 + (tile >> 2); u.pn = tile & 3; u.boff = 0; u.koff = (long)hf * kslice * 2; u.nt = KH > 1 ? (kslice >> 6) : 0; return true;
    }
    __device__ __forceinline__ void a_ready(const Unit&) const {}
    __device__ __forceinline__ void done(const Unit&) const {}
};
template <bool ACCUM, bool ALWAYS_ALT> struct EpiGateBr {
    static constexpr bool PERM = true, AFTER_DRAIN = false;
    bf16_t* O; int ldc; const bf16_t* G; int ldg; bf16_t* ALT;
    __device__ __forceinline__ void operator()(const f32x4 (&acc)[2][2][4][2], const Unit& u, int wr, int wc, int fr, int fq) const {
        const int row0 = u.pm * BM + wr * 64 + fr, col0 = u.pn * BM + wc * 32 + 8 * fq;
        const bool ctx = u.pm >= 64, alt = ctx && (ALWAYS_ALT || u.koff != 0), accum = ACCUM && !ctx;
        bf16_t* ob = alt ? ALT - (size_t)64 * BM * ldc : O;
#pragma unroll
        for (int ai = 0; ai < 2; ++ai) {
            u32x4 gq[4][2], oq[4][2];
#pragma unroll
            for (int m = 0; m < 4; ++m) { const int row = row0 + ai * HALF + m * 16; const bf16_t* gp = G + (size_t)row * ldg + col0; const bf16_t* rowp = ob + (size_t)row * ldc + col0;
#pragma unroll
                for (int bj = 0; bj < 2; ++bj) { gq[m][bj] = *(const u32x4*)(gp + bj * HALF); if (accum) oq[m][bj] = *(const u32x4*)(rowp + bj * HALF); } }
#pragma unroll
            for (int m = 0; m < 4; ++m) { const int row = row0 + ai * HALF + m * 16; bf16_t* rowp = ob + (size_t)row * ldc + col0;
#pragma unroll
                for (int bj = 0; bj < 2; ++bj) { const f32x4 v0 = acc[ai][bj][m][0], v1 = acc[ai][bj][m][1];
                    const u32x4 g = gq[m][bj];
                    float r[8];
                    r[0] = sigmoidf_(bflo(g.x)) * v0[0]; r[1] = sigmoidf_(bfhi(g.x)) * v0[1]; r[2] = sigmoidf_(bflo(g.y)) * v0[2]; r[3] = sigmoidf_(bfhi(g.y)) * v0[3];
                    r[4] = sigmoidf_(bflo(g.z)) * v1[0]; r[5] = sigmoidf_(bfhi(g.z)) * v1[1]; r[6] = sigmoidf_(bflo(g.w)) * v1[2]; r[7] = sigmoidf_(bfhi(g.w)) * v1[3];
                    if (accum) { const u32x4 o = oq[m][bj];
                        r[0] += bflo(o.x); r[1] += bfhi(o.x); r[2] += bflo(o.y); r[3] += bfhi(o.y); r[4] += bflo(o.z); r[5] += bfhi(o.z); r[6] += bflo(o.w); r[7] += bfhi(o.w); }
                    u32x4 w; w.x = cvt_pk_bf16(r[0], r[1]); w.y = cvt_pk_bf16(r[2], r[3]); w.z = cvt_pk_bf16(r[4], r[5]); w.w = cvt_pk_bf16(r[6], r[7]);
                    *(u32x4*)(rowp + bj * HALF) = w; } }
            asm volatile("" ::: "memory"); }
    }
};
struct CtxSplit3Order {
    StaticOrder lat; int G, c, nsub; long a1, a2;
    __device__ __forceinline__ void init(int Mlat, int G_, int c_, long a1_, long a2_, int nsub_) { lat.init(Mlat, 1024, G_, c_); G = G_; c = c_; a1 = a1_; a2 = a2_; nsub = nsub_; }
    __device__ __forceinline__ bool next(int i, Unit& u) const {
        if (lat.next(i, u)) return true;
        const int j = i * G + c - lat.nwg;
        if (j >= nsub) return false;
        const int tile = j / 12, r = j % 12, s = r >> 2, ks = r & 3;
        const long aA = s == 0 ? 0L : (s == 1 ? a1 : a2);
        u.pm = 64 + (tile >> 2); u.pn = tile & 3; u.koff = (long)ks * 512 + aA; u.boff = -aA; u.nt = (r << 8) | 4; return true;
    }
    __device__ __forceinline__ void a_ready(const Unit&) const {}
    __device__ __forceinline__ void done(const Unit&) const {}
};
struct EpiStoreSplit3 {
    static constexpr bool PERM = true, AFTER_DRAIN = false;
    bf16_t* O; int ldc; bf16_t* Pslab;
    __device__ __forceinline__ void operator()(const f32x4 (&acc)[2][2][4][2], const Unit& u, int wr, int wc, int fr, int fq) const {
        const int col0 = u.pn * BM + wc * 32 + 8 * fq;
        bf16_t* base; int row0;
        if (u.pm < 64) { base = O; row0 = u.pm * BM + wr * 64 + fr; }
        else { base = Pslab + (size_t)(u.nt >> 8) * 1024 * ldc; row0 = (u.pm - 64) * BM + wr * 64 + fr; }
#pragma unroll
        for (int ai = 0; ai < 2; ++ai)
#pragma unroll
            for (int m = 0; m < 4; ++m) { bf16_t* rowp = base + (size_t)(row0 + ai * HALF + m * 16) * ldc + col0;
#pragma unroll
                for (int bj = 0; bj < 2; ++bj) { const f32x4 v0 = acc[ai][bj][m][0], v1 = acc[ai][bj][m][1];
                    u32x4 w; w.x = cvt_pk_bf16(v0[0], v0[1]); w.y = cvt_pk_bf16(v0[2], v0[3]); w.z = cvt_pk_bf16(v1[0], v1[1]); w.w = cvt_pk_bf16(v1[2], v1[3]);
                    *(u32x4*)(rowp + bj * HALF) = w; } }
    }
};
struct EpiStoreSplit {
    static constexpr bool PERM = true, AFTER_DRAIN = false;
    bf16_t* O; int ldc; bf16_t* Pslab; int slice2;
    __device__ __forceinline__ void operator()(const f32x4 (&acc)[2][2][4][2], const Unit& u, int wr, int wc, int fr, int fq) const {
        const int col0 = u.pn * BM + wc * 32 + 8 * fq;
        bf16_t* base; int row0;
        if (u.pm < 64) { base = O; row0 = u.pm * BM + wr * 64 + fr; }
        else { base = Pslab + (size_t)(int)(u.koff / slice2) * 1024 * ldc; row0 = (u.pm - 64) * BM + wr * 64 + fr; }
#pragma unroll
        for (int ai = 0; ai < 2; ++ai)
#pragma unroll
            for (int m = 0; m < 4; ++m) { bf16_t* rowp = base + (size_t)(row0 + ai * HALF + m * 16) * ldc + col0;
#pragma unroll
                for (int bj = 0; bj < 2; ++bj) { const f32x4 v0 = acc[ai][bj][m][0], v1 = acc[ai][bj][m][1];
                    u32x4 w; w.x = cvt_pk_bf16(v0[0], v0[1]); w.y = cvt_pk_bf16(v0[2], v0[3]); w.z = cvt_pk_bf16(v1[0], v1[1]); w.w = cvt_pk_bf16(v1[2], v1[3]);
                    *(u32x4*)(rowp + bj * HALF) = w; } }
    }
};

struct EpiMoeDown {
    static constexpr bool PERM = true, AFTER_DRAIN = false;
    bf16_t* O; int ldc; bf16_t* SL; int slice2, split_tile; size_t slab_stride;
    __device__ __forceinline__ void operator()(const f32x4 (&acc)[2][2][4][2], const Unit& u, int wr, int wc, int fr, int fq) const {
        const int col0 = u.pn * BM + wc * 32 + 8 * fq;
        bf16_t* base; int row0;
        if (u.nt == 0) { base = O; row0 = u.pm * BM + wr * 64 + fr; }
        else { base = SL + (size_t)(int)(u.koff / slice2) * slab_stride; row0 = (u.pm - split_tile) * BM + wr * 64 + fr; }
#pragma unroll
        for (int ai = 0; ai < 2; ++ai)
#pragma unroll
            for (int m = 0; m < 4; ++m) { bf16_t* rowp = base + (size_t)(row0 + ai * HALF + m * 16) * ldc + col0;
#pragma unroll
                for (int bj = 0; bj < 2; ++bj) { const f32x4 v0 = acc[ai][bj][m][0], v1 = acc[ai][bj][m][1];
                    u32x4 w; w.x = cvt_pk_bf16(v0[0], v0[1]); w.y = cvt_pk_bf16(v0[2], v0[3]); w.z = cvt_pk_bf16(v1[0], v1[1]); w.w = cvt_pk_bf16(v1[2], v1[3]);
                    *(u32x4*)(rowp + bj * HALF) = w; } }
    }
};

struct EpiProj {
    static constexpr bool PERM = true, AFTER_DRAIN = false;
    bf16_t* O; int ldc; bf16_t* NVT; int nv0; int nblk;
    __device__ __forceinline__ void operator()(const f32x4 (&acc)[2][2][4][2], const Unit& u, int wr, int wc, int fr, int fq) const {
        const int row0 = u.pm * BM + wr * 64 + fr;
        if (u.pn != nv0 && u.pn != nv0 + 1) {
            const int col0 = u.pn * BM + wc * 32 + 8 * fq;
#pragma unroll
            for (int ai = 0; ai < 2; ++ai)
#pragma unroll
                for (int m = 0; m < 4; ++m) { bf16_t* rowp = O + (size_t)(row0 + ai * HALF + m * 16) * ldc + col0;
#pragma unroll
                    for (int bj = 0; bj < 2; ++bj) { const f32x4 v0 = acc[ai][bj][m][0], v1 = acc[ai][bj][m][1];
                        u32x4 w; w.x = cvt_pk_bf16(v0[0], v0[1]); w.y = cvt_pk_bf16(v0[2], v0[3]); w.z = cvt_pk_bf16(v1[0], v1[1]); w.w = cvt_pk_bf16(v1[2], v1[3]);
                        *(u32x4*)(rowp + bj * HALF) = w; } }
        } else {
#pragma unroll
            for (int ai = 0; ai < 2; ++ai)
#pragma unroll
                for (int m = 0; m < 4; ++m) { const int row = row0 + ai * HALF + m * 16;
#pragma unroll
                    for (int bj = 0; bj < 2; ++bj) { const int cl = bj * HALF + wc * 32 + 8 * fq; const int h = 4 * (u.pn - nv0) + (cl >> 6), d0 = cl & 63;
                        bf16_t* p = NVT + (((size_t)h * nblk + (row >> 3)) * 64 + d0) * 8 + (row & 7);
                        const f32x4 v0 = acc[ai][bj][m][0], v1 = acc[ai][bj][m][1];
                        const unsigned w0 = cvt_pk_bf16(v0[0], v0[1]), w1 = cvt_pk_bf16(v0[2], v0[3]), w2 = cvt_pk_bf16(v1[0], v1[1]), w3 = cvt_pk_bf16(v1[2], v1[3]);
                        p[0] = (bf16_t)(w0 & 0xffffu); p[8] = (bf16_t)(w0 >> 16); p[16] = (bf16_t)(w1 & 0xffffu); p[24] = (bf16_t)(w1 >> 16);
                        p[32] = (bf16_t)(w2 & 0xffffu); p[40] = (bf16_t)(w2 >> 16); p[48] = (bf16_t)(w3 & 0xffffu); p[56] = (bf16_t)(w3 >> 16); }
                    asm volatile("" ::: "memory"); }
        }
    }
};
template <class Epi, class Sched, bool ALIGN_EPI = false, bool SP2 = false, bool F8 = false>
__device__ __forceinline__ void gemm_phase(PG8_LAS unsigned char* lds, const Gemm g, const Sched& S, const Epi& E, int scaleW = 127, int scaleA = 127) {
    int tid_ = threadIdx.x; asm volatile("" : "+v"(tid_)); const int tid = tid_, wid = __builtin_amdgcn_readfirstlane(tid >> 6), lane = tid & 63, wr = wid >> 2, wc = wid & 3, fr = lane & 15, fq = lane >> 4;
    int scW_ = scaleW, scA_ = scaleA; (void)scW_; (void)scA_;
    const int K = g.K, ntf = K / BK;
    unsigned voffA[2], voffB[2];
#pragma unroll
    for (int i = 0; i < 2; ++i) { int R, C; stage_rc(tid * 16 + i * 8192, R, C); const int Rb = Epi::PERM ? ((R & ~31) + perm32(R & 31)) : R;
        voffA[i] = (unsigned)(R * K + C) * 2u; voffB[i] = (unsigned)(Rb * K + C) * 2u; }
    const size_t kstep = (size_t)(BK * 2);
    const size_t hstep = (size_t)HALF * K * 2;
    const size_t tstep = 2 * hstep;
    const unsigned ldsw = (unsigned)wid * 1024u;
    const int aoff = lds_byte(wr * 64 + fr, fq * 8), boff = lds_byte(wc * 32 + fr, fq * 8);
#define PG8_SA(b, h) (((b) * 2 + (h)) * HTB)
#define PG8_SB(b, h) ((4 + (b) * 2 + (h)) * HTB)
#define PG8_STAGE(bufoff, gbase, voff) do { _Pragma("unroll") for (int _i = 0; _i < 2; ++_i) \
        __builtin_amdgcn_global_load_lds((const unsigned*)((const char*)(gbase) + (voff)[_i]), (PG8_LAS unsigned*)(lds + (bufoff) + ldsw + _i * 8192), 16, 0, 0); } while (0)
#define PG8_LDA(dst, b, h) do { _Pragma("unroll") for (int m = 0; m < 4; ++m) _Pragma("unroll") for (int k = 0; k < 2; ++k) dst[m][k] = *(const PG8_LAS bf16x8*)(lds + PG8_SA(b, h) + aoff + m * 2048 + k * 1024); } while (0)
#define PG8_LDB(dst, b, h) do { _Pragma("unroll") for (int n = 0; n < 2; ++n) _Pragma("unroll") for (int k = 0; k < 2; ++k) dst[n][k] = *(const PG8_LAS bf16x8*)(lds + PG8_SB(b, h) + boff + n * 2048 + k * 1024); } while (0)
#define PG8_MMA(ai, bj, At, Bt) do { __builtin_amdgcn_s_setprio(1); _Pragma("unroll") for (int m = 0; m < 4; ++m) _Pragma("unroll") for (int n = 0; n < 2; ++n) { \
        if constexpr (F8) { struct P2_ { bf16x8 lo, hi; }; const P2_ pb_{Bt[n][0], Bt[n][1]}, pa_{At[m][0], At[m][1]}; \
            const v8i_t b8_ = __builtin_bit_cast(v8i_t, pb_), a8_ = __builtin_bit_cast(v8i_t, pa_); \
            asm volatile("v_mfma_scale_f32_16x16x128_f8f6f4 %0, %1, %2, %0, %3, %4 op_sel_hi:[0,0,0]" : "+v"(acc[ai][bj][m][n]) : "v"(b8_), "v"(a8_), "v"(scW_), "v"(scA_)); } \
        else { _Pragma("unroll") for (int k = 0; k < 2; ++k) acc[ai][bj][m][n] = __builtin_amdgcn_mfma_f32_16x16x32_bf16(Bt[n][k], At[m][k], acc[ai][bj][m][n], 0, 0, 0); } } \
        __builtin_amdgcn_s_setprio(0); } while (0)
#define PG8_WAIT_V(n) asm volatile("s_waitcnt vmcnt(" #n ")" ::: "memory")
#define PG8_WAIT_L(n) asm volatile("s_waitcnt lgkmcnt(" #n ")" ::: "memory")
#define PG8_BAR __builtin_amdgcn_s_barrier()
#define PG8_SCHED __builtin_amdgcn_sched_barrier(0)
    Unit cur, nxt; int ui = 0;
    if (!S.next(0, cur)) return;
    f32x4 acc[2][2][4][2];
#pragma unroll
    for (int a = 0; a < 2; ++a)
#pragma unroll
        for (int b = 0; b < 2; ++b)
#pragma unroll
            for (int m = 0; m < 4; ++m)
#pragma unroll
                for (int n = 0; n < 2; ++n) acc[a][b][m][n] = (f32x4){0.f, 0.f, 0.f, 0.f};
    bf16x8 At[4][2], B0[2][2], B1[2][2];
    const char* cA = (const char*)g.A + cur.koff + (size_t)cur.pm * tstep; const char* cB = (const char*)g.Bt + cur.boff + cur.koff + (size_t)cur.pn * tstep;
    S.a_ready(cur);
    if constexpr (SP2) {
        PG8_STAGE(PG8_SB(0, 0), cB, voffB); PG8_STAGE(PG8_SB(0, 1), cB + hstep, voffB); PG8_STAGE(PG8_SA(0, 0), cA, voffA); PG8_STAGE(PG8_SA(0, 1), cA + hstep, voffA);
        if (wr == 1) PG8_BAR;
        PG8_WAIT_V(2); PG8_BAR;
        PG8_STAGE(PG8_SB(1, 0), cB + kstep, voffB); PG8_STAGE(PG8_SA(1, 0), cA + kstep, voffA); PG8_STAGE(PG8_SB(1, 1), cB + hstep + kstep, voffB);
        PG8_WAIT_V(6); PG8_BAR;
    } else {
        PG8_STAGE(PG8_SB(0, 0), cB, voffB); PG8_STAGE(PG8_SA(0, 0), cA, voffA); PG8_STAGE(PG8_SB(0, 1), cB + hstep, voffB); PG8_STAGE(PG8_SA(0, 1), cA + hstep, voffA);
        if (wr == 1) PG8_BAR;
        PG8_WAIT_V(4); PG8_BAR;
        PG8_STAGE(PG8_SB(1, 0), cB + kstep, voffB); PG8_STAGE(PG8_SA(1, 0), cA + kstep, voffA); PG8_STAGE(PG8_SB(1, 1), cB + hstep + kstep, voffB);
        PG8_WAIT_V(6); PG8_BAR;
    }
    for (;;) {
        const bool has_next = S.next(ui + 1, nxt);
        const char* nA = has_next ? (const char*)g.A + nxt.koff + (size_t)nxt.pm * tstep : cA; const char* nB = has_next ? (const char*)g.Bt + nxt.boff + nxt.koff + (size_t)nxt.pn * tstep : cB;
        int nt = (cur.nt & 255) ? (cur.nt & 255) : ntf; asm volatile("" : "+s"(nt));
        for (int t = 0; t < nt; t += 2) {
            const bool last = (t == nt - 2);
            const char* a1 = cA + (size_t)(t + 1) * kstep;
            const char* a2 = last ? nA : cA + (size_t)(t + 2) * kstep; const char* b2 = last ? nB : cB + (size_t)(t + 2) * kstep;
            const char* a3 = a2 + kstep; const char* b3 = b2 + kstep;
            if (last && has_next) S.a_ready(nxt);
            if constexpr (SP2) {
            PG8_LDB(B0, 0, 0); PG8_LDB(B1, 0, 1); PG8_SCHED; PG8_LDA(At, 0, 0); PG8_STAGE(PG8_SA(1, 1), a1 + hstep, voffA);
            PG8_WAIT_V(8); PG8_WAIT_L(0); PG8_BAR; PG8_MMA(0, 0, At, B0); PG8_MMA(0, 1, At, B1); PG8_BAR; PG8_SCHED;
            PG8_LDA(At, 0, 1); PG8_STAGE(PG8_SB(0, 0), b2, voffB); PG8_STAGE(PG8_SB(0, 1), b2 + hstep, voffB); PG8_STAGE(PG8_SA(0, 0), a2, voffA);
            PG8_WAIT_V(8); PG8_WAIT_L(0); PG8_BAR; PG8_MMA(1, 0, At, B0); PG8_MMA(1, 1, At, B1); PG8_BAR; PG8_SCHED;
            PG8_LDB(B0, 1, 0); PG8_LDB(B1, 1, 1); PG8_SCHED; PG8_LDA(At, 1, 0); PG8_STAGE(PG8_SA(0, 1), a2 + hstep, voffA);
            PG8_WAIT_V(8); PG8_WAIT_L(0); PG8_BAR; PG8_MMA(0, 0, At, B0); PG8_MMA(0, 1, At, B1); PG8_BAR; PG8_SCHED;
            PG8_LDA(At, 1, 1); PG8_STAGE(PG8_SB(1, 0), b3, voffB); PG8_STAGE(PG8_SB(1, 1), b3 + hstep, voffB); PG8_STAGE(PG8_SA(1, 0), a3, voffA);
            PG8_WAIT_V(8); PG8_WAIT_L(0); PG8_BAR; PG8_MMA(1, 0, At, B0); PG8_MMA(1, 1, At, B1); PG8_BAR; PG8_SCHED;
            } else {
            PG8_LDB(B0, 0, 0); PG8_SCHED; PG8_LDA(At, 0, 0); PG8_STAGE(PG8_SA(1, 1), a1 + hstep, voffA);
            PG8_WAIT_L(8); PG8_BAR; PG8_WAIT_L(0); PG8_MMA(0, 0, At, B0); PG8_BAR; PG8_SCHED;
            PG8_LDB(B1, 0, 1); PG8_STAGE(PG8_SB(0, 0), b2, voffB);
            PG8_BAR; PG8_WAIT_L(0); PG8_MMA(0, 1, At, B1); PG8_BAR;
            PG8_LDA(At, 0, 1); PG8_STAGE(PG8_SA(0, 0), a2, voffA);
            PG8_BAR; PG8_WAIT_L(0); PG8_MMA(1, 0, At, B0); PG8_BAR; PG8_SCHED;
            PG8_STAGE(PG8_SB(0, 1), b2 + hstep, voffB);
            PG8_WAIT_V(6); PG8_BAR; PG8_MMA(1, 1, At, B1); PG8_BAR;
            PG8_LDB(B0, 1, 0); PG8_SCHED; PG8_LDA(At, 1, 0); PG8_STAGE(PG8_SA(0, 1), a2 + hstep, voffA);
            PG8_WAIT_L(8); PG8_BAR; PG8_WAIT_L(0); PG8_MMA(0, 0, At, B0); PG8_BAR; PG8_SCHED;
            PG8_LDB(B1, 1, 1); PG8_STAGE(PG8_SB(1, 0), b3, voffB);
            PG8_BAR; PG8_WAIT_L(0); PG8_MMA(0, 1, At, B1); PG8_BAR;
            PG8_LDA(At, 1, 1); PG8_STAGE(PG8_SA(1, 0), a3, voffA);
            PG8_BAR; PG8_WAIT_L(0); PG8_MMA(1, 0, At, B0); PG8_BAR; PG8_SCHED;
            PG8_STAGE(PG8_SB(1, 1), b3 + hstep, voffB);
            PG8_WAIT_V(6); PG8_BAR; PG8_MMA(1, 1, At, B1); PG8_BAR;
            }
        }
        if constexpr (F8) asm volatile("s_nop 15\n\ts_nop 15\n\ts_nop 15\n\ts_nop 15\n\ts_nop 15\n\ts_nop 15" ::: "memory");
        if constexpr (ALIGN_EPI) { if (wr == 0) PG8_BAR; }
        if constexpr (!Epi::AFTER_DRAIN) { E(acc, cur, wr, wc, fr, fq); S.done(cur); }
        if (!has_next) break;
#pragma unroll
        for (int a = 0; a < 2; ++a)
#pragma unroll
            for (int b = 0; b < 2; ++b)
#pragma unroll
                for (int m = 0; m < 4; ++m)
#pragma unroll
                    for (int n = 0; n < 2; ++n) acc[a][b][m][n] = (f32x4){0.f, 0.f, 0.f, 0.f};
        cur = nxt; cA = nA; cB = nB; ++ui;
        if constexpr (ALIGN_EPI) { if (wr == 1) PG8_BAR; }
    }
    PG8_WAIT_V(0);
    if constexpr (!ALIGN_EPI) { if (wr == 0) PG8_BAR; }
    PG8_BAR;
    if constexpr (Epi::AFTER_DRAIN) { E.fused(acc, cur, wr, wc, fr, fq, lds, wid, lane); S.done(cur); }
#undef PG8_SA
#undef PG8_SB
#undef PG8_STAGE
#undef PG8_LDA
#undef PG8_LDB
#undef PG8_MMA
#undef PG8_WAIT_V
#undef PG8_WAIT_L
#undef PG8_BAR
#undef PG8_SCHED
}
}

#ifndef PG8_SP2
#define PG8_SP2 true
#endif
#ifndef PG8_ALIGN
#define PG8_ALIGN true
#endif
#ifndef SITE_PROJ
#define SITE_PROJ 1
#endif
#ifndef SITE_BR
#define SITE_BR 1
#endif
#ifndef SITE_OUT
#define SITE_OUT 1
#endif
#ifndef SITE_UP
#define SITE_UP 1
#endif
#ifndef SITE_DOWN
#define SITE_DOWN 1
#endif
#ifndef SITE_THIN
#define SITE_THIN 1
#endif
#ifndef DENSE_FP8
#define DENSE_FP8 1
#endif
#ifndef MK_MULTI
#define MK_MULTI 0
#endif

constexpr int NWAVES = 8;
constexpr int D = 1024, BATCH = 4, SEQ = 4096, DEPTH = 4, CTX = 256;
constexpr int TL = BATCH * SEQ, TC = BATCH * CTX, T = TL + TC;
constexpr int DFF = 3584, NEXP = 8, DIN = 6688;
constexpr int NPROJ = 7680;
constexpr int PC_GQ = 0, PC_GK = 512, PC_GV = 1024, PC_GR = 2048, PC_ZF = 3072, PC_ZB = 3584, PC_NQ = 4096, PC_NK = 4608, PC_NV = 5120, PC_GA = 5632, PC_GB = 6656;
constexpr float EPS = 1e-6f;
enum { I_X = 0, I_C, I_CTX, I_CCTX, I_WMOD, I_BMOD, I_NMPRE, I_NMPOST, I_WIN, I_GW2, I_GB, I_GNORM, I_RPB, I_WBG, I_WBN, I_WOUT, I_NFPRE, I_NFPOST, I_F1, I_F3, I_F2, I_ROUTER, I_M1, I_M3, I_M2, N_IN };

constexpr size_t MiB = 1u << 20;
constexpr size_t WS_CTL = 0, CTL_ZERO_BYTES = 1 * MiB;
constexpr size_t WS_MODS = 1 * MiB;
constexpr size_t WS_ROPE = WS_MODS + 512 * 1024;
constexpr size_t WS_SLOT = 2 * MiB;
constexpr size_t WS_WT = WS_SLOT + 512 * 1024;
constexpr size_t WS_DEST = WS_WT + 256 * 1024;
constexpr size_t WS_CNTW = WS_DEST + 256 * 1024;
constexpr size_t WS_WIN = 4 * MiB;
constexpr size_t WS_WBG = WS_WIN + 4 * 15 * MiB;
constexpr size_t WS_WBN = WS_WBG + 4 * 2 * MiB;
constexpr size_t WS_WO = WS_WBN + 4 * 1 * MiB;
constexpr size_t WS_W13 = WS_WO + 4 * 2 * MiB;
constexpr size_t WS_W2 = WS_W13 + 18 * 14 * MiB;
constexpr size_t WS_X = WS_W2 + 18 * 7 * MiB;
constexpr size_t WS_H = WS_X + 68 * MiB;
constexpr size_t WS_YN = WS_H;
constexpr size_t WS_NK = WS_H + 17 * MiB;
constexpr size_t WS_A = WS_H + 34 * MiB;
constexpr size_t WS_PROJ = WS_A;
constexpr size_t WS_GBLK = WS_PROJ + 255 * MiB;
constexpr size_t WS_VTB = WS_GBLK + 77 * MiB;
constexpr size_t WS_OINTRA = WS_VTB + 39 * MiB;
constexpr size_t WS_OIF = WS_OINTRA + 34 * MiB;
constexpr size_t WS_OIB = WS_OIF + 34 * MiB;
constexpr size_t WS_NVT = WS_OIB + 34 * MiB;
constexpr size_t WS_YC = WS_OIB;
constexpr size_t WS_FC = WS_OIB + 8 * MiB;
constexpr size_t WS_YG = WS_OINTRA;
constexpr size_t WS_MB = WS_GBLK;
constexpr size_t WS_MB2 = WS_MB + 36 * MiB;
constexpr size_t WS_MB3 = WS_MB + 38 * MiB;
constexpr size_t WS_Y = WS_OIF;
constexpr int MOE_MAXROWS = 143 * 256;
constexpr size_t WS_XG = WS_A;
constexpr size_t WS_HID = WS_XG + 72 * MiB;
constexpr size_t WS_FS = WS_HID + 251 * MiB;
constexpr size_t WS_END = WS_NVT + 17 * MiB;
static_assert(WS_END <= 1065 * MiB, "workspace map exceeds the guaranteed size");
static_assert(WS_FS + 72 * MiB <= WS_Y, "ffn overlay ends below Y (read by post_mix only, but keep clear)");
constexpr int GB_QE = 0, GB_KDT = 17408, GB_DEC = 35840, GB_BYTES = 36864, VT_BYTES = 36864;
constexpr int CW_BAR = 4096;
constexpr int CW_MOE = 12288;

constexpr int RING_BYTES = 131072;
constexpr int LDSCTL_OFF = 143360, MISC_OFF = LDSCTL_OFF + 320;
constexpr int LDS_BYTES = 147456;

#define GAS __attribute__((address_space(1)))
#define LAS __attribute__((address_space(3)))
typedef unsigned short bf16;
typedef unsigned v4u __attribute__((ext_vector_type(4)));
typedef unsigned v2u __attribute__((ext_vector_type(2)));
typedef float f32x4 __attribute__((ext_vector_type(4)));
typedef float f32x2 __attribute__((ext_vector_type(2)));
typedef GAS unsigned gu32;
#define RLX_AGENT __ATOMIC_RELAXED, __HIP_MEMORY_SCOPE_AGENT
#define LDS_WAIT() asm volatile("s_waitcnt lgkmcnt(0)" ::: "memory")
#define VM_WAIT() asm volatile("s_waitcnt vmcnt(0)" ::: "memory")
using pg8::bflo; using pg8::bfhi; using pg8::cvt_pk_bf16;
__device__ __forceinline__ float bf2f(bf16 h) { return __uint_as_float((unsigned)h << 16); }
__device__ __forceinline__ float wave_sum(float v) {
    v += __builtin_bit_cast(float, __builtin_amdgcn_update_dpp(0, __builtin_bit_cast(int, v), 0x111, 0xf, 0xf, true));
    v += __builtin_bit_cast(float, __builtin_amdgcn_update_dpp(0, __builtin_bit_cast(int, v), 0x112, 0xf, 0xf, true));
    v += __builtin_bit_cast(float, __builtin_amdgcn_update_dpp(0, __builtin_bit_cast(int, v), 0x114, 0xf, 0xf, true));
    v += __builtin_bit_cast(float, __builtin_amdgcn_update_dpp(0, __builtin_bit_cast(int, v), 0x118, 0xf, 0xf, true));
    v += __builtin_bit_cast(float, __builtin_amdgcn_update_dpp(0, __builtin_bit_cast(int, v), 0x142, 0xa, 0xf, false));
    v += __builtin_bit_cast(float, __builtin_amdgcn_update_dpp(0, __builtin_bit_cast(int, v), 0x143, 0xc, 0xf, false));
    return __int_as_float(__builtin_amdgcn_readlane(__float_as_int(v), 63));
}
__device__ __forceinline__ float wave_max(float v) {
#pragma unroll
    for (int o = 1; o < 64; o <<= 1) v = fmaxf(v, __shfl_xor(v, o));
    return v;
}
__device__ __forceinline__ float sq4(f32x4 v) { return (v.x * v.x + v.y * v.y) + (v.z * v.z + v.w * v.w); }
__device__ __forceinline__ f32x4 unpack4(v2u w) { return (f32x4){bflo(w.x), bfhi(w.x), bflo(w.y), bfhi(w.y)}; }
__device__ __forceinline__ v2u pack4(f32x4 v) { v2u w; w.x = cvt_pk_bf16(v.x, v.y); w.y = cvt_pk_bf16(v.z, v.w); return w; }
__device__ __forceinline__ float siluf_(float x) { return x * pg8::sigmoidf_(x); }

#define XB_TMO      128
#define XB_XCNT(j)  (256  + 64 * (j))
#define XB_XSUB(j)  (1280 + 64 * (j))
#define XB_XGEN(j)  (2304 + 64 * (j))
#define XB_TOP      3328
#define XB_TOPGEN   3392
#define XCD_BAR_WORDS 3456
#define XB_SPIN_CAP (1u << 18)

__device__ __forceinline__ unsigned xb_ld(unsigned* p)              { return __hip_atomic_load(p, __ATOMIC_RELAXED, __HIP_MEMORY_SCOPE_AGENT); }
__device__ __forceinline__ unsigned xb_add(unsigned* p, unsigned v) { return __hip_atomic_fetch_add(p, v, __ATOMIC_RELAXED, __HIP_MEMORY_SCOPE_AGENT); }
__device__ __forceinline__ unsigned xb_xcc_id() { return (unsigned)__builtin_amdgcn_s_getreg((3 << 11) | 20) & 0xFu; }
#define XB_SPIN(cond, bar) do { unsigned _sp = 0; while (cond) { __builtin_amdgcn_s_sleep(1); \
    if ((++_sp & 255u) == 0u) { if (xb_ld(&(bar)[XB_TMO])) break; if (_sp > XB_SPIN_CAP) { atomicAdd(&(bar)[XB_TMO], 1u); break; } } } } while (0)

struct XcdBarrier {
    unsigned* bar; unsigned x;
    volatile LAS unsigned* st;
};

__device__ __forceinline__ XcdBarrier xcd_barrier_post(unsigned* bar, volatile LAS unsigned* st) {
    XcdBarrier b; b.bar = bar; b.x = xb_xcc_id(); b.st = st;
    if (threadIdx.x == 0) (void)xb_add(&bar[XB_XCNT(b.x)], 1u);
    return b;
}
__device__ __forceinline__ void xcd_barrier_complete(unsigned* bar, unsigned x, unsigned& nloc, unsigned& nx) {
    const unsigned G = gridDim.x * gridDim.y * gridDim.z;
    unsigned sum, cnt, mine, sp = 0u;
    for (;;) {
        sum = 0u; cnt = 0u; mine = 0u;
        unsigned cj[16];
#pragma unroll
        for (unsigned j = 0; j < 16; ++j) cj[j] = xb_ld(&bar[XB_XCNT(j)]);
        asm volatile("" ::: "memory");
#pragma unroll
        for (unsigned j = 0; j < 16; ++j) { const unsigned c = cj[j]; sum += c; cnt += (c > 0u) ? 1u : 0u; mine = (j == x) ? c : mine; }
        if (sum == G) break;
        __builtin_amdgcn_s_sleep(1);
        if ((++sp & 255u) == 0u) { if (xb_ld(&bar[XB_TMO])) break; if (sp > XB_SPIN_CAP) { atomicAdd(&bar[XB_TMO], 1u); break; } }
    }
    nloc = mine > 0u ? mine : 1u; nx = cnt > 0u ? cnt : 1u;
}

template <bool CENSUS = true> __device__ __forceinline__ void xcd_barrier(const XcdBarrier& b) {
    asm volatile("s_waitcnt vmcnt(0)" ::: "memory");
    __syncthreads();
    if (threadIdx.x == 0) {
        unsigned* bar = b.bar; asm volatile("" : "+s"(bar));
        __builtin_amdgcn_s_waitcnt(0);
        unsigned nloc = b.st[0], nx = b.st[1];
        if (CENSUS && nloc == 0u) { xcd_barrier_complete(bar, b.x, nloc, nx); b.st[0] = nloc; b.st[1] = nx; }
        const unsigned old = xb_add(&bar[XB_XSUB(b.x)], 1u);
        const unsigned gen = old / nloc;
        if (old == gen * nloc && nloc > 1u) __builtin_amdgcn_fence(__ATOMIC_RELEASE, "agent");
        if (old + 1u == (gen + 1u) * nloc) {
            __builtin_amdgcn_fence(__ATOMIC_RELEASE, "agent");
            asm volatile("s_waitcnt vmcnt(0)" ::: "memory");
            const unsigned og = xb_add(&bar[XB_TOP], 1u);
            const unsigned tg = og / nx;
            if (og + 1u == (tg + 1u) * nx) xb_add(&bar[XB_TOPGEN], 1u);
            else XB_SPIN(xb_ld(&bar[XB_TOPGEN]) == tg, bar);
            __builtin_amdgcn_fence(__ATOMIC_ACQUIRE, "agent");
            asm volatile("s_waitcnt vmcnt(0)" ::: "memory");
        } else {
            XB_SPIN(xb_ld(&bar[XB_TOPGEN]) == gen, bar);
            __builtin_amdgcn_fence(__ATOMIC_ACQUIRE, "agent");
            asm volatile("s_waitcnt vmcnt(0)" ::: "memory");
        }
    }
    __syncthreads();
}


__device__ __forceinline__ int otid() { int t = threadIdx.x; asm volatile("" : "+v"(t)); return t; }
typedef const float* const __attribute__((address_space(4)))* KIN;
struct Frame {
    LAS unsigned char* lds;
    int tid, lane, wave, G, bx;
    KIN in;
    unsigned char* ws;
    float* out;
};
#define WSP(T_, off) ((T_*)(F.ws + (off)))

__device__ __forceinline__ void p0_transpose_item(const float* W, int K, int N, int kb, int nb, bf16* WT, int drow0, LAS float* scr, int lane) {
    const int k0 = 64 * kb, n0 = 32 * nb;
    f32x4 t[8];
#pragma unroll
    for (int i = 0; i < 8; ++i) t[i] = *(const f32x4*)(W + (size_t)(k0 + 8 * i + (lane >> 3)) * N + n0 + 4 * (lane & 7));
#pragma unroll
    for (int i = 0; i < 8; ++i) *(LAS f32x4*)(scr + (8 * i + (lane >> 3)) * 36 + 4 * (lane & 7)) = t[i];
    LDS_WAIT(); asm volatile("" ::: "memory");
    const int c = lane & 7;
#pragma unroll
    for (int j = 0; j < 4; ++j) { const int n = (lane >> 3) + 8 * j; const LAS float* s = scr + (8 * c) * 36 + n;
        v4u o; o.x = cvt_pk_bf16(s[0 * 36], s[1 * 36]); o.y = cvt_pk_bf16(s[2 * 36], s[3 * 36]); o.z = cvt_pk_bf16(s[4 * 36], s[5 * 36]); o.w = cvt_pk_bf16(s[6 * 36], s[7 * 36]);
        *(GAS v4u*)(WT + (size_t)(drow0 + n) * K + k0 + 8 * c) = o; }
    LDS_WAIT(); asm volatile("" ::: "memory");
}
__device__ __forceinline__ void p0_transpose_item_f8(const float* W, int K, int N, int kb, int nb, unsigned char* WT, int drow0, LAS float* scr, int lane) {
    const int k0 = 64 * kb, n0 = 32 * nb;
    f32x4 t[8];
#pragma unroll
    for (int i = 0; i < 8; ++i) t[i] = *(const f32x4*)(W + (size_t)(k0 + 8 * i + (lane >> 3)) * N + n0 + 4 * (lane & 7));
#pragma unroll
    for (int i = 0; i < 8; ++i) *(LAS f32x4*)(scr + (8 * i + (lane >> 3)) * 36 + 4 * (lane & 7)) = t[i] * 32.0f;
    LDS_WAIT(); asm volatile("" ::: "memory");
    const int c = lane & 3;
#pragma unroll
    for (int j = 0; j < 2; ++j) { const int n = (lane >> 2) + 16 * j; const LAS float* s = scr + (16 * c) * 36 + n;
        v4u o; o.x = pg8::pk4_fp8(s[0 * 36], s[1 * 36], s[2 * 36], s[3 * 36]); o.y = pg8::pk4_fp8(s[4 * 36], s[5 * 36], s[6 * 36], s[7 * 36]);
        o.z = pg8::pk4_fp8(s[8 * 36], s[9 * 36], s[10 * 36], s[11 * 36]); o.w = pg8::pk4_fp8(s[12 * 36], s[13 * 36], s[14 * 36], s[15 * 36]);
        *(GAS v4u*)(WT + (size_t)(drow0 + n) * K + k0 + 16 * c) = o; }
    LDS_WAIT(); asm volatile("" ::: "memory");
}
struct G0Item { const float* W; unsigned char* WT; int K, N, k0, n0, drow0, f8; };
__device__ __forceinline__ bool g0_decode(Frame& F, int it, G0Item& d) {
    static_assert(DENSE_FP8 == 1, "the FFN items below are 128-k fp8 blocks");
    constexpr int IT_WIN = 16 * 209, IT_BG = 16 * 32, IT_BN = 8 * 32, IT_WO = 16 * 32, IT_LAYER = IT_WIN + IT_BG + IT_BN + IT_WO, IT_FF = 8 * 112, IT_SET = 3 * IT_FF;
    if (it < 4 * IT_LAYER) {
        const int l = it / IT_LAYER; int r = it % IT_LAYER; d.f8 = 0;
        if (r < IT_WIN) { const int kb = r / 209, nb = r % 209; if (nb == 96) return false;
            d.W = F.in[I_WIN] + (size_t)l * D * DIN; d.K = D; d.N = DIN; d.k0 = 64 * kb; d.n0 = 32 * nb; d.WT = F.ws + WS_WIN + (size_t)l * NPROJ * D * 2; d.drow0 = nb < 96 ? 32 * nb : 32 * nb + 992; return true; }
        r -= IT_WIN;
        if (r < IT_BG) { d.W = F.in[I_WBG] + (size_t)l * D * D; d.K = D; d.N = D; d.k0 = 64 * (r / 32); d.n0 = 32 * (r % 32); d.WT = F.ws + WS_WBG + (size_t)l * D * D * 2; d.drow0 = d.n0; return true; }
        r -= IT_BG;
        if (r < IT_BN) { d.W = F.in[I_WBN] + (size_t)l * 512 * D; d.K = 512; d.N = D; d.k0 = 64 * (r / 32); d.n0 = 32 * (r % 32); d.WT = F.ws + WS_WBN + (size_t)l * D * 512 * 2; d.drow0 = d.n0; return true; }
        r -= IT_BN;
        d.W = F.in[I_WOUT] + (size_t)l * D * D; d.K = D; d.N = D; d.k0 = 64 * (r / 32); d.n0 = 32 * (r % 32); d.WT = F.ws + WS_WO + (size_t)l * D * D * 2; d.drow0 = d.n0; return true;
    }
    const int it2 = it - 4 * IT_LAYER; const int s = it2 / IT_SET; int r = it2 % IT_SET; const int which = r / IT_FF; r %= IT_FF;
    const size_t so = (size_t)(s < 2 ? s : s - 2) * D * DFF;
    d.f8 = (DENSE_FP8 || s >= 2) ? 1 : 0;
    if (which < 2) {
        d.W = (s < 2 ? (which ? F.in[I_F3] : F.in[I_F1]) : (which ? F.in[I_M3] : F.in[I_M1])) + so; d.K = D; d.N = DFF;
        const int kb = r / 112, nb = r % 112; const int c0 = 32 * nb; d.k0 = 128 * kb; d.n0 = c0; d.drow0 = (c0 >> 7) * 256 + which * 128 + (c0 & 127);
        d.WT = F.ws + WS_W13 + (size_t)s * 7168 * D * 2;
    } else {
        d.W = (s < 2 ? F.in[I_F2] : F.in[I_M2]) + so; d.K = DFF; d.N = D; d.k0 = 128 * (r / 32); d.n0 = 32 * (r % 32); d.drow0 = d.n0;
        d.WT = F.ws + WS_W2 + (size_t)s * D * DFF * 2;
    }
    return true;
}
__device__ __forceinline__ void g0_load(const G0Item& d, int lane, f32x4 (&t)[16]) {
#pragma unroll
    for (int i = 0; i < 8; ++i) t[i] = __builtin_nontemporal_load((const GAS f32x4*)(d.W + (size_t)(d.k0 + 8 * i + (lane >> 3)) * d.N + d.n0 + 4 * (lane & 7)));
    if (d.f8) {
#pragma unroll
        for (int i = 8; i < 16; ++i) t[i] = __builtin_nontemporal_load((const GAS f32x4*)(d.W + (size_t)(d.k0 + 8 * i + (lane >> 3)) * d.N + d.n0 + 4 * (lane & 7))); }
}
__device__ __forceinline__ void g0_finish(const G0Item& d, const f32x4 (&t)[16], LAS float* scr, int lane) {
    if (d.f8) {
#pragma unroll
        for (int i = 0; i < 16; ++i) { LAS f32x2* q = (LAS f32x2*)(scr + (8 * i + (lane >> 3)) * 34 + 4 * (lane & 7)); const f32x4 v = t[i] * 32.0f; q[0] = (f32x2){v.x, v.y}; q[1] = (f32x2){v.z, v.w}; }
    } else {
#pragma unroll
        for (int i = 0; i < 8; ++i) *(LAS f32x4*)(scr + (8 * i + (lane >> 3)) * 36 + 4 * (lane & 7)) = t[i];
    }
    LDS_WAIT(); asm volatile("" ::: "memory");
    if (d.f8) { const int n = lane & 31;
#pragma unroll
        for (int j = 0; j < 4; ++j) { const int c = (lane >> 5) + 2 * j; const LAS float* s = scr + (16 * c) * 34 + n;
            v4u o; o.x = pg8::pk4_fp8(s[0 * 34], s[1 * 34], s[2 * 34], s[3 * 34]); o.y = pg8::pk4_fp8(s[4 * 34], s[5 * 34], s[6 * 34], s[7 * 34]);
            o.z = pg8::pk4_fp8(s[8 * 34], s[9 * 34], s[10 * 34], s[11 * 34]); o.w = pg8::pk4_fp8(s[12 * 34], s[13 * 34], s[14 * 34], s[15 * 34]);
            *(GAS v4u*)(d.WT + (size_t)(d.drow0 + n) * d.K + d.k0 + 16 * c) = o; }
    } else { const int c = lane & 7;
#pragma unroll
        for (int j = 0; j < 4; ++j) { const int n = (lane >> 3) + 8 * j; const LAS float* s = scr + (8 * c) * 36 + n;
            v4u o; o.x = cvt_pk_bf16(s[0 * 36], s[1 * 36]); o.y = cvt_pk_bf16(s[2 * 36], s[3 * 36]); o.z = cvt_pk_bf16(s[4 * 36], s[5 * 36]); o.w = cvt_pk_bf16(s[6 * 36], s[7 * 36]);
            *(GAS v4u*)(d.WT + ((size_t)(d.drow0 + n) * d.K + d.k0 + 8 * c) * 2) = o; }
    }
    LDS_WAIT(); asm volatile("" ::: "memory");
}
__device__ __forceinline__ void phase_g0(Frame& F) {
    LAS float* scr = (LAS float*)(F.lds + F.wave * 17920);
    const int gw = F.bx * NWAVES + F.wave, NGW = F.G * NWAVES;
    constexpr int IT_WIN = 16 * 209, IT_BG = 16 * 32, IT_BN = 8 * 32, IT_WO = 16 * 32, IT_LAYER = IT_WIN + IT_BG + IT_BN + IT_WO;
    constexpr int IT_FF = 8 * 112, IT_SET = 3 * IT_FF, IT_TOTAL = 4 * IT_LAYER + 18 * IT_SET;
    {
        G0Item cur, nxt; f32x4 tc[16], tn[16];
        int it = gw; bool have = false;
        for (; it < IT_TOTAL; it += NGW) if (g0_decode(F, it, cur)) { have = true; break; }
        if (have) g0_load(cur, F.lane, tc);
        while (have) {
            bool hn = false;
            for (it += NGW; it < IT_TOTAL; it += NGW) if (g0_decode(F, it, nxt)) { hn = true; break; }
            if (hn) g0_load(nxt, F.lane, tn);
            g0_finish(cur, tc, scr, F.lane);
            cur = nxt; have = hn;
#pragma unroll
            for (int i = 0; i < 16; ++i) tc[i] = tn[i];
        }
    }
    {
        const int gt = F.bx * (NWAVES * 64) + F.tid, NGT = F.G * NWAVES * 64;
        for (int it = gt; it < 4 * 2 * 16 * 512; it += NGT) {
            const int n = it & 511, kb = (it >> 9) & 15, dir = (it >> 13) & 1, l = it >> 14;
            const float* w2 = F.in[I_GW2] + ((size_t)(l * 2 + dir) * 16) * 512 + n;
            float w2r[16];
#pragma unroll
            for (int r = 0; r < 16; ++r) w2r[r] = w2[r * 512];
            bf16* dst = WSP(bf16, WS_WIN) + ((size_t)l * NPROJ + 3072 + 512 * dir + n) * D + 64 * kb;
            for (int k8 = 0; k8 < 8; ++k8) {
                float o[8];
#pragma unroll
                for (int kk = 0; kk < 8; ++kk) { const f32x4* a = (const f32x4*)(F.in[I_WIN] + ((size_t)l * D + 64 * kb + 8 * k8 + kk) * DIN + 3072 + 16 * dir); float s = 0.f;
#pragma unroll
                    for (int r4 = 0; r4 < 4; ++r4) { const f32x4 av = a[r4]; s += av.x * w2r[4 * r4] + av.y * w2r[4 * r4 + 1] + av.z * w2r[4 * r4 + 2] + av.w * w2r[4 * r4 + 3]; }
                    o[kk] = s; }
                v4u w; w.x = cvt_pk_bf16(o[0], o[1]); w.y = cvt_pk_bf16(o[2], o[3]); w.z = cvt_pk_bf16(o[4], o[5]); w.w = cvt_pk_bf16(o[6], o[7]);
                *(GAS v4u*)(dst + 8 * k8) = w;
            }
        }
        for (int it = gt; it < 64 * 32; it += NGT) { const int pos = it >> 5, i = it & 31;
            const float inv = exp2f(-(float)i * (13.287712379549449f / 32.0f)); const float rev = (float)pos * inv * 0.15915494309189535f;
            WSP(f32x2, WS_ROPE)[it] = (f32x2){__builtin_amdgcn_cosf(rev), __builtin_amdgcn_sinf(rev)}; }
    }
    __syncthreads();
    {
        LAS float* S = (LAS float*)F.lds;
        LAS float* PS = (LAS float*)(F.lds + 32768);
        { float cv_[10];
#pragma unroll
          for (int k = 0; k < 10; ++k) { const int i = F.tid + 512 * k; cv_[k] = i < 4096 ? ((const GAS float*)F.in[I_C])[i] : ((const GAS float*)F.in[I_CCTX])[i - 4096]; }
#pragma unroll
          for (int k = 0; k < 10; ++k) S[F.tid + 512 * k] = siluf_(cv_[k]); }
        __syncthreads();
        for (int it = F.bx; it < 4 * 192; it += F.G) {
            const int l = it / 192, nb = it % 192;
            const float* W = F.in[I_WMOD] + (size_t)l * D * 6144 + 32 * nb + 4 * (F.lane & 7);
            const int k0 = F.wave * 128 + (F.lane >> 3);
            f32x4 wv[16];
#pragma unroll
            for (int i = 0; i < 16; ++i) wv[i] = *(const f32x4*)(W + (size_t)(k0 + 8 * i) * 6144);
            f32x4 acc[5];
#pragma unroll
            for (int r = 0; r < 5; ++r) acc[r] = (f32x4){0.f, 0.f, 0.f, 0.f};
#pragma unroll
            for (int i = 0; i < 16; ++i)
#pragma unroll
                for (int r = 0; r < 5; ++r) acc[r] += wv[i] * S[r * 1024 + k0 + 8 * i];
#pragma unroll
            for (int r = 0; r < 5; ++r) *(LAS f32x4*)(PS + ((F.wave * 64 + F.lane) * 5 + r) * 4) = acc[r];
            __syncthreads();
            if (F.tid < 160) { const int r = F.tid >> 5, cn = F.tid & 31, cg = cn >> 2, comp = cn & 3; float s = F.in[I_BMOD][l * 6144 + 32 * nb + cn];
                for (int w = 0; w < 8; ++w)
#pragma unroll
                    for (int gq = 0; gq < 8; ++gq) s += PS[((w * 64 + gq * 8 + cg) * 5 + r) * 4 + comp];
                WSP(float, WS_MODS)[(size_t)(l * 5 + r) * 6144 + 32 * nb + cn] = s; }
            __syncthreads();
        }
    }
}

__device__ __forceinline__ void ld_row_f32(const float* p, int lane, f32x4 (&v)[4]) {
#pragma unroll
    for (int j = 0; j < 4; ++j) v[j] = __builtin_nontemporal_load((const GAS f32x4*)(p + 256 * j + 4 * lane));
}
__device__ __forceinline__ void ld_row_bf16(const bf16* p, int lane, f32x4 (&v)[4]) {
#pragma unroll
    for (int j = 0; j < 4; ++j) v[j] = unpack4(*(const v2u*)(p + 256 * j + 4 * lane));
}
__device__ __forceinline__ void st_row_f32(float* p, int lane, const f32x4 (&v)[4]) {
#pragma unroll
    for (int j = 0; j < 4; ++j) __builtin_nontemporal_store(v[j], (f32x4*)(p + 256 * j + 4 * lane));
}
__device__ __forceinline__ void st_row_bf16(bf16* p, int lane, const f32x4 (&v)[4]) {
#pragma unroll
    for (int j = 0; j < 4; ++j) __builtin_nontemporal_store(pack4(v[j]), (v2u*)(p + 256 * j + 4 * lane));
}
__device__ __forceinline__ void ldraw(const bf16* p, int lane, v2u (&v)[4]) {
#pragma unroll
    for (int j = 0; j < 4; ++j) v[j] = __builtin_nontemporal_load((const GAS v2u*)(p + 256 * j + 4 * lane));
}
__device__ __forceinline__ void unraw(const v2u (&v)[4], f32x4 (&o)[4]) {
#pragma unroll
    for (int j = 0; j < 4; ++j) o[j] = unpack4(v[j]);
}
__device__ __forceinline__ float row_rstd(const f32x4 (&v)[4]) { const float ss = (sq4(v[0]) + sq4(v[1])) + (sq4(v[2]) + sq4(v[3])); return rsqrtf(wave_sum(ss) * (1.0f / 1024.0f) + EPS); }
__device__ __forceinline__ void normmod(const f32x4 (&x)[4], const float* g, const float* shift, const float* scale, int lane, f32x4 (&h)[4]) {
    const float rs = row_rstd(x);
#pragma unroll
    for (int j = 0; j < 4; ++j) { const int c = 256 * j + 4 * lane; const f32x4 gv = *(const f32x4*)(g + c), sh = *(const f32x4*)(shift + c), sc = *(const f32x4*)(scale + c);
        h[j] = (x[j] * rs * gv) * (sc + 1.0f) + sh; }
}
#ifndef NS_G1
#define NS_G1 2
#endif
#ifndef NS_GO
#define NS_GO 2
#endif
#ifndef NS_PM
#define NS_PM 2
#endif
template <int NT> __device__ __forceinline__ void stage_tabs(LAS float* TB, const float* const (&src)[NT], const int (&slot)[NT], int tid) {
    if (tid < 256) { f32x4 tv[NT];
#pragma unroll
        for (int k = 0; k < NT; ++k) tv[k] = ((const GAS f32x4*)src[k])[tid];
#pragma unroll
        for (int k = 0; k < NT; ++k) ((LAS f32x4*)(TB + slot[k] * 1024))[tid] = tv[k]; }
}
__device__ __forceinline__ f32x4 tabv(const LAS float* t, int j, int lane) { return *(const LAS f32x4*)(t + 256 * j + 4 * lane); }
__device__ __forceinline__ void normmod_l(const f32x4 (&x)[4], const LAS float* g, const LAS float* shift, const LAS float* scale, int lane, f32x4 (&h)[4]) {
    const float rs = row_rstd(x);
#pragma unroll
    for (int j = 0; j < 4; ++j) h[j] = (x[j] * rs * tabv(g, j, lane)) * (tabv(scale, j, lane) + 1.0f) + tabv(shift, j, lane);
}
__device__ __forceinline__ void cpraw(v2u (&d)[4], const v2u (&s)[4]) {
#pragma unroll
    for (int j = 0; j < 4; ++j) d[j] = s[j];
}
__device__ __forceinline__ void g1_row(Frame& F, int row, const f32x4 (&x)[4], const LAS float* TB) {
    const int mr = row < TL ? (row >> 12) : 4; f32x4 h[4];
    st_row_bf16(WSP(bf16, WS_X) + (size_t)row * D, F.lane, x);
    normmod_l(x, TB, TB + (1 + mr) * 1024, TB + (6 + mr) * 1024, F.lane, h); st_row_bf16(WSP(bf16, WS_H) + (size_t)row * D, F.lane, h);
}
__device__ __forceinline__ void phase_g1(Frame& F) {
    const int gw = F.bx * NWAVES + F.wave, NGW = F.G * NWAVES;
    LAS float* TB = (LAS float*)F.lds;
    { const float* md = WSP(float, WS_MODS);
      const float* const src[11] = {F.in[I_NMPRE], md, md + 6144, md + 2 * 6144, md + 3 * 6144, md + 4 * 6144, md + 1024, md + 6144 + 1024, md + 2 * 6144 + 1024, md + 3 * 6144 + 1024, md + 4 * 6144 + 1024};
      const int slot[11] = {0, 1, 2, 3, 4, 5, 6, 7, 8, 9, 10};
      stage_tabs<11>(TB, src, slot, F.tid); }
    __syncthreads();
#define G1_SRC(row_) ((row_) < TL ? F.in[I_X] + (size_t)(row_) * D : F.in[I_CTX] + (size_t)((row_) - TL) * D)
    f32x4 nr[NS_G1][4];
#pragma unroll
    for (int s = 0; s < NS_G1; ++s) if (gw + s * NGW < T) ld_row_f32(G1_SRC(gw + s * NGW), F.lane, nr[s]);
    for (int row = gw; row < T; row += NS_G1 * NGW) {
        f32x4 cr[NS_G1][4];
#pragma unroll
        for (int s = 0; s < NS_G1; ++s)
#pragma unroll
            for (int j = 0; j < 4; ++j) cr[s][j] = nr[s][j];
#pragma unroll
        for (int s = 0; s < NS_G1; ++s) if (row + (NS_G1 + s) * NGW < T) ld_row_f32(G1_SRC(row + (NS_G1 + s) * NGW), F.lane, nr[s]);
#pragma unroll
        for (int s = 0; s < NS_G1; ++s) if (row + s * NGW < T) g1_row(F, row + s * NGW, cr[s], TB);
    }
#undef G1_SRC
}
#define TROWS(l) ((l) == DEPTH - 1 ? TL : T)
__device__ __forceinline__ void glaout_row(Frame& F, int row, f32x4 (&a)[4], const f32x4 (&b)[4], const f32x4 (&c)[4], const f32x4 (&r)[4], const f32x4 (&gv)[4]) {
#pragma unroll
    for (int j = 0; j < 4; ++j) {
        const f32x4 o = a[j] + b[j] + c[j]; const float rs = rsqrtf(wave_sum(sq4(o)) * (1.0f / 256.0f) + EPS);
        f32x4 y = o * rs * gv[j]; y.x *= siluf_(r[j].x); y.y *= siluf_(r[j].y); y.z *= siluf_(r[j].z); y.w *= siluf_(r[j].w); a[j] = y; }
    st_row_bf16(WSP(bf16, WS_YG) + (size_t)row * D, F.lane, a);
}
__device__ __forceinline__ void phase_gla_out(Frame& F, int l) {
    const int gw = F.bx * NWAVES + F.wave, NGW = F.G * NWAVES, NR = TROWS(l);
    f32x4 gv[4];
#pragma unroll
    for (int j = 0; j < 4; ++j) gv[j] = *(const f32x4*)(F.in[I_GNORM] + l * 1024 + 256 * j + 4 * F.lane);
#define GLAOUT_LOAD(row_, A_, B_, C_, R_) do { ldraw(WSP(bf16, WS_OINTRA) + (size_t)(row_) * D, F.lane, A_); ldraw(WSP(bf16, WS_OIF) + (size_t)(row_) * D, F.lane, B_); ldraw(WSP(bf16, WS_OIB) + (size_t)(row_) * D, F.lane, C_); \
        ldraw(WSP(bf16, WS_PROJ) + (size_t)(row_) * NPROJ + PC_GR, F.lane, R_); } while (0)
    v2u na[NS_GO][4], nb[NS_GO][4], nc[NS_GO][4], nr[NS_GO][4];
#pragma unroll
    for (int s = 0; s < NS_GO; ++s) if (gw + s * NGW < NR) GLAOUT_LOAD(gw + s * NGW, na[s], nb[s], nc[s], nr[s]);
    for (int row = gw; row < NR; row += NS_GO * NGW) {
#pragma unroll
        for (int s = 0; s < NS_GO; ++s) { const int r_ = row + s * NGW;
            if (r_ < NR) { f32x4 a[4], b[4], c[4], r[4]; unraw(na[s], a); unraw(nb[s], b); unraw(nc[s], c); unraw(nr[s], r);
                if (r_ + NS_GO * NGW < NR) GLAOUT_LOAD(r_ + NS_GO * NGW, na[s], nb[s], nc[s], nr[s]);
                glaout_row(F, r_, a, b, c, r, gv); } }
    }
#undef GLAOUT_LOAD
}
__device__ __forceinline__ void pmix_row(Frame& F, int l, int row, f32x4 (&y)[4], f32x4 (&x)[4], const LAS float* TB, const LAS float* WR, LAS unsigned* LCNT, bool moe) {
    const int mr = row < TL ? (row >> 12) : 4;
    f32x4 h[4];
    if (row >= TL) {
        const bf16* yc = WSP(bf16, WS_YC) + (size_t)(row - TL) * D;
        { v2u sl[6][4];
#pragma unroll
          for (int ks = 0; ks < 6; ++ks) ldraw(yc + (size_t)(ks + 1) * TC * D, F.lane, sl[ks]);
#pragma unroll
          for (int ks = 0; ks < 6; ++ks) { f32x4 y2[4]; unraw(sl[ks], y2);
#pragma unroll
              for (int j = 0; j < 4; ++j) y[j] += y2[j]; } }
        { v2u sl[5][4];
#pragma unroll
          for (int ks = 0; ks < 5; ++ks) ldraw(yc + (size_t)(ks + 7) * TC * D, F.lane, sl[ks]);
#pragma unroll
          for (int ks = 0; ks < 5; ++ks) { f32x4 y2[4]; unraw(sl[ks], y2);
#pragma unroll
              for (int j = 0; j < 4; ++j) y[j] += y2[j]; } } }
    const float rs = row_rstd(y);
#pragma unroll
    for (int j = 0; j < 4; ++j) x[j] += tabv(TB + mr * 1024, j, F.lane) * (y[j] * rs * tabv(TB + 5 * 1024, j, F.lane));
    st_row_bf16(WSP(bf16, WS_X) + (size_t)row * D, F.lane, x);
    normmod_l(x, TB + 6 * 1024, TB + (7 + mr) * 1024, TB + (12 + mr) * 1024, F.lane, h);
    if (DENSE_FP8 || moe) { unsigned char* h8 = WSP(unsigned char, WS_H) + (size_t)row * D;
#pragma unroll
      for (int j = 0; j < 4; ++j) __builtin_nontemporal_store(pg8::pk4_fp8(h[j].x, h[j].y, h[j].z, h[j].w), (unsigned*)(h8 + 256 * j + 4 * F.lane)); }
    else st_row_bf16(WSP(bf16, WS_H) + (size_t)row * D, F.lane, h);
    if (moe) {
        float lg[8] = {0.f, 0.f, 0.f, 0.f, 0.f, 0.f, 0.f, 0.f};
#pragma unroll
        for (int j = 0; j < 4; ++j)
#pragma unroll
            for (int i = 0; i < 4; ++i) { const LAS f32x4* w = (const LAS f32x4*)(WR + ((j * 4 + i) * 64 + F.lane) * 8); const f32x4 w0 = w[0], w1 = w[1]; const float hv = h[j][i];
                lg[0] += hv * w0.x; lg[1] += hv * w0.y; lg[2] += hv * w0.z; lg[3] += hv * w0.w; lg[4] += hv * w1.x; lg[5] += hv * w1.y; lg[6] += hv * w1.z; lg[7] += hv * w1.w; }
#pragma unroll
        for (int e = 0; e < 8; ++e) lg[e] = wave_sum(lg[e]);
        int i1 = 0; float v1 = lg[0];
#pragma unroll
        for (int e = 1; e < 8; ++e) if (lg[e] > v1) { v1 = lg[e]; i1 = e; }
        int i2 = -1; float v2 = -3.0e38f;
#pragma unroll
        for (int e = 0; e < 8; ++e) if (e != i1 && lg[e] > v2) { v2 = lg[e]; i2 = e; }
        const float e2 = __expf(v2 - v1), inv = 1.0f / (1.0f + e2);
        if (F.lane == 0) {
            WSP(f32x2, WS_WT)[row] = (f32x2){inv, e2 * inv};
            (void)__hip_atomic_fetch_add(LCNT + i1, 1u, __ATOMIC_RELAXED, __HIP_MEMORY_SCOPE_WORKGROUP); (void)__hip_atomic_fetch_add(LCNT + i2, 1u, __ATOMIC_RELAXED, __HIP_MEMORY_SCOPE_WORKGROUP);
            WSP(int, WS_SLOT)[2 * (size_t)row] = i1; WSP(int, WS_SLOT)[2 * (size_t)row + 1] = i2;
        }
    }
}
__device__ __forceinline__ void phase_post_mix(Frame& F, int l) {
    const int gw = F.bx * NWAVES + F.wave, NGW = F.G * NWAVES, NR = TROWS(l); const bool moe = (l & 1) != 0;
    LAS float* TB = (LAS float*)F.lds;
    LAS float* WR = (LAS float*)(F.lds + 17 * 4096);
    LAS unsigned* LCNT = (LAS unsigned*)(F.lds + 17 * 4096 + 32768);
    { const float* md = WSP(float, WS_MODS) + (size_t)(l * 5) * 6144;
      const float* const src[17] = {md + 2048, md + 6144 + 2048, md + 2 * 6144 + 2048, md + 3 * 6144 + 2048, md + 4 * 6144 + 2048, F.in[I_NMPOST] + l * 1024, F.in[I_NFPRE] + l * 1024,
          md + 3072, md + 6144 + 3072, md + 2 * 6144 + 3072, md + 3 * 6144 + 3072, md + 4 * 6144 + 3072, md + 4096, md + 6144 + 4096, md + 2 * 6144 + 4096, md + 3 * 6144 + 4096, md + 4 * 6144 + 4096};
      const int slot[17] = {0, 1, 2, 3, 4, 5, 6, 7, 8, 9, 10, 11, 12, 13, 14, 15, 16};
      stage_tabs<17>(TB, src, slot, F.tid); }
    if (moe) { const float* wr = F.in[I_ROUTER] + (size_t)(l >> 1) * D * NEXP;
        for (int c = F.tid; c < D; c += NWAVES * 64) { const int j = c >> 8, ln = (c >> 2) & 63, i = c & 3; LAS f32x4* dst = (LAS f32x4*)(WR + ((j * 4 + i) * 64 + ln) * 8); const f32x4* src = (const f32x4*)(wr + (size_t)c * 8); dst[0] = src[0]; dst[1] = src[1]; }
        if (F.tid < 16) LCNT[F.tid] = 0u; }
#define PMIX_LOAD(row_, Y_, X_) do { ldraw((row_) < TL ? WSP(bf16, WS_Y) + (size_t)(row_) * D : WSP(bf16, WS_YC) + (size_t)((row_) - TL) * D, F.lane, Y_); ldraw(WSP(bf16, WS_X) + (size_t)(row_) * D, F.lane, X_); } while (0)
    v2u ny[NS_PM][4], nx[NS_PM][4];
#pragma unroll
    for (int s = 0; s < NS_PM; ++s) if (gw + s * NGW < NR) PMIX_LOAD(gw + s * NGW, ny[s], nx[s]);
    __syncthreads();
    for (int row = gw; row < NR; row += NS_PM * NGW) {
#pragma unroll
        for (int s = 0; s < NS_PM; ++s) { const int r_ = row + s * NGW;
            if (r_ < NR) { f32x4 y[4], x[4]; unraw(ny[s], y); unraw(nx[s], x);
                if (r_ + NS_PM * NGW < NR) PMIX_LOAD(r_ + NS_PM * NGW, ny[s], nx[s]);
                pmix_row(F, l, r_, y, x, TB, WR, LCNT, moe); } }
    }
#undef PMIX_LOAD
    if (moe) {
        __syncthreads();
        if (F.tid < 8) { const unsigned cv = LCNT[F.tid]; WSP(int, WS_CNTW)[F.bx * 8 + F.tid] = (int)cv;
            (void)__hip_atomic_fetch_add((unsigned*)(F.ws + WS_CTL) + CW_MOE + 64 * (l >> 1) + F.tid, cv, __ATOMIC_RELAXED, __HIP_MEMORY_SCOPE_AGENT); }
    }
}
__device__ __forceinline__ void moe_counts(Frame& F, int j, int (&cnt)[8]) {
    unsigned v[8];
#pragma unroll
    for (int e = 0; e < 8; ++e) v[e] = __hip_atomic_load((unsigned*)(F.ws + WS_CTL) + CW_MOE + 64 * j + e, __ATOMIC_RELAXED, __HIP_MEMORY_SCOPE_AGENT);
    asm volatile("" ::: "memory");
#pragma unroll
    for (int e = 0; e < 8; ++e) cnt[e] = __builtin_amdgcn_readfirstlane((int)v[e]);
}
constexpr int MOE_SL_ROWS = 16 * 256;
__device__ __forceinline__ int moe_split_tile(const int (&cnt)[8], int G) {
    int nt = 0;
#pragma unroll
    for (int e = 0; e < 8; ++e) nt += (cnt[e] + 255) >> 8;
    int s = (4 * nt - 2 * G + 3) >> 2; s = s < 0 ? 0 : (s > 15 ? 15 : s);
    return (4 * nt <= 2 * G || 4 * nt > 3 * G) ? nt : nt - s;
}
__device__ __forceinline__ void phase_moe_gather(Frame& F, int l) {
    const int gw = F.bx * NWAVES + F.wave, NGW = F.G * NWAVES, NR = TROWS(l);
    LAS int* CW = (LAS int*)F.lds;
    LAS int* BASE = (LAS int*)(F.lds + 16384);
    LAS int* TE = (LAS int*)(F.lds + 16384 + 128);
    v4u ar[9];
#pragma unroll
    for (int k = 0; k < 9; ++k) { const int row = gw + k * NGW; if (row < NR) ar[k] = __builtin_nontemporal_load((const GAS v4u*)(WSP(unsigned char, WS_H) + (size_t)row * D) + F.lane); }
    { int cv_[4];
#pragma unroll
      for (int k = 0; k < 4; ++k) { const int i = F.tid + 512 * k; cv_[k] = i < F.G * 8 ? ((const GAS int*)WSP(int, WS_CNTW))[i] : 0; }
#pragma unroll
      for (int k = 0; k < 4; ++k) { const int i = F.tid + 512 * k; if (i < F.G * 8) CW[i] = cv_[k]; } }
    if (F.lane < 9) { const int row = gw + F.lane * NGW; int e1 = -1, e2 = -1; if (row < NR) { e1 = WSP(int, WS_SLOT)[2 * (size_t)row]; e2 = WSP(int, WS_SLOT)[2 * (size_t)row + 1]; }
        TE[(F.wave * 9 + F.lane) * 2] = e1; TE[(F.wave * 9 + F.lane) * 2 + 1] = e2; }
    __syncthreads();
    { const int e = F.wave; float tot = 0.f, below = 0.f;
      for (int wgi = F.lane; wgi < F.G; wgi += 64) { const float cv = (float)CW[wgi * 8 + e]; tot += cv; below += wgi < F.bx ? cv : 0.f; }
      tot = wave_sum(tot); below = wave_sum(below);
      if (F.lane == 0) { BASE[e] = (int)below; BASE[16 + e] = (int)tot; } }
    __syncthreads();
    if (F.tid == 0) { int o = 0; for (int e = 0; e < 8; ++e) { BASE[8 + e] = o; o += ((BASE[16 + e] + 255) >> 8) << 8; } }
    __syncthreads();
    const int sl0 = F.lane, sl1 = F.lane + 64;
    const int t0a = TE[sl0 * 2], t0b = TE[sl0 * 2 + 1]; const int t1a = sl1 < 72 ? TE[sl1 * 2] : -1, t1b = sl1 < 72 ? TE[sl1 * 2 + 1] : -1;
#pragma unroll
    for (int k = 0; k < 9; ++k) { const int row = gw + k * NGW;
        if (row < NR) {
            const int me = F.wave * 9 + k; const int e1 = TE[me * 2], e2 = TE[me * 2 + 1];
            const int r1 = __popcll(__ballot((sl0 < me) && (t0a == e1 || t0b == e1))) + __popcll(__ballot((sl1 < me) && (t1a == e1 || t1b == e1)));
            const int r2 = __popcll(__ballot((sl0 < me) && (t0a == e2 || t0b == e2))) + __popcll(__ballot((sl1 < me) && (t1a == e2 || t1b == e2)));
            const int d1 = BASE[8 + e1] + BASE[e1] + r1, d2 = BASE[8 + e2] + BASE[e2] + r2;
            __builtin_nontemporal_store(ar[k], (v4u*)(WSP(unsigned char, WS_XG) + (size_t)d1 * D) + F.lane); __builtin_nontemporal_store(ar[k], (v4u*)(WSP(unsigned char, WS_XG) + (size_t)d2 * D) + F.lane);
            if (F.lane == 0) { WSP(int, WS_DEST)[2 * (size_t)row] = d1; WSP(int, WS_DEST)[2 * (size_t)row + 1] = d2; } } }
}
__device__ __forceinline__ void pffn_row(Frame& F, int l, int row, f32x4 (&f)[4], f32x4 (&f2)[4], f32x4 (&x)[4], int d1c, int d2c, f32x2 wt, int srow, bool moe, const LAS float* TB) {
    const int mr = row < TL ? (row >> 12) : 4;
    f32x4 h[4];
    if (moe) {
        if (d1c >= srow) {
            v2u sl[6][4];
#pragma unroll
            for (int ks = 0; ks < 6; ++ks) ldraw(WSP(bf16, WS_XG) + ((size_t)(ks + 1) * MOE_SL_ROWS + (d1c - srow)) * D, F.lane, sl[ks]);
#pragma unroll
            for (int ks = 0; ks < 6; ++ks) { f32x4 t[4]; unraw(sl[ks], t);
#pragma unroll
                for (int j = 0; j < 4; ++j) f[j] += t[j]; } }
        if (d2c >= srow) {
            v2u sl[6][4];
#pragma unroll
            for (int ks = 0; ks < 6; ++ks) ldraw(WSP(bf16, WS_XG) + ((size_t)(ks + 1) * MOE_SL_ROWS + (d2c - srow)) * D, F.lane, sl[ks]);
#pragma unroll
            for (int ks = 0; ks < 6; ++ks) { f32x4 t[4]; unraw(sl[ks], t);
#pragma unroll
                for (int j = 0; j < 4; ++j) f2[j] += t[j]; } }
#pragma unroll
        for (int j = 0; j < 4; ++j) f[j] = f[j] * wt.x + f2[j] * wt.y; }
    if (!moe && row >= TL) {
        v2u sl[6][4];
#pragma unroll
        for (int ks = 0; ks < 6; ++ks) ldraw(WSP(bf16, WS_FC) + ((size_t)(ks + 1) * TC + (row - TL)) * D, F.lane, sl[ks]);
#pragma unroll
        for (int ks = 0; ks < 6; ++ks) { f32x4 t[4]; unraw(sl[ks], t);
#pragma unroll
            for (int j = 0; j < 4; ++j) f[j] += t[j]; } }
    const float rs = row_rstd(f);
#pragma unroll
    for (int j = 0; j < 4; ++j) x[j] += tabv(TB + mr * 1024, j, F.lane) * (f[j] * rs * tabv(TB + 5 * 1024, j, F.lane));
    if (l == DEPTH - 1) { st_row_f32(F.out + (size_t)row * D, F.lane, x); return; }
    st_row_bf16(WSP(bf16, WS_X) + (size_t)row * D, F.lane, x);
    normmod_l(x, TB + 6 * 1024, TB + (7 + mr) * 1024, TB + (12 + mr) * 1024, F.lane, h); st_row_bf16(WSP(bf16, WS_H) + (size_t)row * D, F.lane, h);
}
__device__ __forceinline__ void phase_post_ffn(Frame& F, int l) {
    const int gw = F.bx * NWAVES + F.wave, NGW = F.G * NWAVES, NR = TROWS(l); const bool moe = (l & 1) != 0;
    LAS float* TB = (LAS float*)F.lds;
    { const float* md = WSP(float, WS_MODS) + (size_t)(l * 5) * 6144;
      if (l < DEPTH - 1) { const float* m2 = md + 5 * 6144;
          const float* const src[17] = {md + 5120, md + 6144 + 5120, md + 2 * 6144 + 5120, md + 3 * 6144 + 5120, md + 4 * 6144 + 5120, F.in[I_NFPOST] + l * 1024, F.in[I_NMPRE] + (l + 1) * 1024,
              m2, m2 + 6144, m2 + 2 * 6144, m2 + 3 * 6144, m2 + 4 * 6144, m2 + 1024, m2 + 6144 + 1024, m2 + 2 * 6144 + 1024, m2 + 3 * 6144 + 1024, m2 + 4 * 6144 + 1024};
          const int slot[17] = {0, 1, 2, 3, 4, 5, 6, 7, 8, 9, 10, 11, 12, 13, 14, 15, 16};
          stage_tabs<17>(TB, src, slot, F.tid); }
      else { const float* const src[6] = {md + 5120, md + 6144 + 5120, md + 2 * 6144 + 5120, md + 3 * 6144 + 5120, md + 4 * 6144 + 5120, F.in[I_NFPOST] + l * 1024};
          const int slot[6] = {0, 1, 2, 3, 4, 5};
          stage_tabs<6>(TB, src, slot, F.tid); } }
    int srow = 0x7fffffff;
    if (moe) { int cnt[8]; moe_counts(F, l >> 1, cnt); srow = moe_split_tile(cnt, F.G) * 256; }
#define PFFN_IDX(row_, D1_, D2_, W_) do { if (moe) { D1_ = WSP(int, WS_DEST)[2 * (size_t)(row_)]; D2_ = WSP(int, WS_DEST)[2 * (size_t)(row_) + 1]; W_ = WSP(f32x2, WS_WT)[(row_)]; } } while (0)
#define PFFN_ROWS(row_, D1_, D2_, RF_, RG_, RX_) do { if (moe) { \
            ldraw(D1_ < srow ? WSP(bf16, WS_FS) + (size_t)D1_ * D : WSP(bf16, WS_XG) + (size_t)(D1_ - srow) * D, F.lane, RF_); ldraw(D2_ < srow ? WSP(bf16, WS_FS) + (size_t)D2_ * D : WSP(bf16, WS_XG) + (size_t)(D2_ - srow) * D, F.lane, RG_); } \
        else ldraw((row_) < TL ? WSP(bf16, WS_FS) + (size_t)(row_) * D : WSP(bf16, WS_FC) + (size_t)((row_) - TL) * D, F.lane, RF_); \
        ldraw(WSP(bf16, WS_X) + (size_t)(row_) * D, F.lane, RX_); } while (0)
    int nd1_0 = 0, nd2_0 = 0, nd1_1 = 0, nd2_1 = 0, fd1_0 = 0, fd2_0 = 0, fd1_1 = 0, fd2_1 = 0;
    float one_ = 1.0f; asm volatile("" : "+v"(one_));
    f32x2 nw_0 = (f32x2){one_, 0.f}, nw_1 = nw_0, fw_0 = nw_0, fw_1 = nw_0;
    v2u nf0[4], ng0[4], nx0[4], nf1[4], ng1[4], nx1[4];
#pragma unroll
    for (int j = 0; j < 4; ++j) { ng0[j] = (v2u){0u, 0u}; ng1[j] = (v2u){0u, 0u}; }
    if (gw < NR) PFFN_IDX(gw, nd1_0, nd2_0, nw_0);
    if (gw + NGW < NR) PFFN_IDX(gw + NGW, nd1_1, nd2_1, nw_1);
    if (gw < NR) PFFN_ROWS(gw, nd1_0, nd2_0, nf0, ng0, nx0);
    if (gw + NGW < NR) PFFN_ROWS(gw + NGW, nd1_1, nd2_1, nf1, ng1, nx1);
    if (gw + 2 * NGW < NR) PFFN_IDX(gw + 2 * NGW, fd1_0, fd2_0, fw_0);
    if (gw + 3 * NGW < NR) PFFN_IDX(gw + 3 * NGW, fd1_1, fd2_1, fw_1);
    __syncthreads();
    for (int row = gw; row < NR; row += 2 * NGW) {
        { f32x4 f[4], f2[4], x[4]; unraw(nf0, f); unraw(ng0, f2); unraw(nx0, x); const int cd1 = nd1_0, cd2 = nd2_0; const f32x2 cw = nw_0;
          if (row + 2 * NGW < NR) { nd1_0 = fd1_0; nd2_0 = fd2_0; nw_0 = fw_0; PFFN_ROWS(row + 2 * NGW, nd1_0, nd2_0, nf0, ng0, nx0); }
          if (row + 4 * NGW < NR) PFFN_IDX(row + 4 * NGW, fd1_0, fd2_0, fw_0);
          pffn_row(F, l, row, f, f2, x, cd1, cd2, cw, srow, moe, TB); }
        if (row + NGW < NR) { f32x4 f[4], f2[4], x[4]; unraw(nf1, f); unraw(ng1, f2); unraw(nx1, x); const int cd1 = nd1_1, cd2 = nd2_1; const f32x2 cw = nw_1;
          if (row + 3 * NGW < NR) { nd1_1 = fd1_1; nd2_1 = fd2_1; nw_1 = fw_1; PFFN_ROWS(row + 3 * NGW, nd1_1, nd2_1, nf1, ng1, nx1); }
          if (row + 5 * NGW < NR) PFFN_IDX(row + 5 * NGW, fd1_1, fd2_1, fw_1);
          pffn_row(F, l, row + NGW, f, f2, x, cd1, cd2, cw, srow, moe, TB); }
    }
#undef PFFN_IDX
#undef PFFN_ROWS
}

typedef short bf16x8v __attribute__((ext_vector_type(8)));
#define MFMA16(a, b, c) __builtin_amdgcn_mfma_f32_16x16x32_bf16((a), (b), (c), 0, 0, 0)
__device__ __forceinline__ bf16 f2bf1(float x) { return (bf16)(cvt_pk_bf16(x, 0.f) & 0xffffu); }
__device__ __forceinline__ void unpack8(v4u w, float* o) { o[0] = bflo(w.x); o[1] = bfhi(w.x); o[2] = bflo(w.y); o[3] = bfhi(w.y); o[4] = bflo(w.z); o[5] = bfhi(w.z); o[6] = bflo(w.w); o[7] = bfhi(w.w); }
__device__ __forceinline__ float dpp_scan64(float v) {
    v += __builtin_bit_cast(float, __builtin_amdgcn_update_dpp(0, __builtin_bit_cast(int, v), 0x111, 0xf, 0xf, true));
    v += __builtin_bit_cast(float, __builtin_amdgcn_update_dpp(0, __builtin_bit_cast(int, v), 0x112, 0xf, 0xf, true));
    v += __builtin_bit_cast(float, __builtin_amdgcn_update_dpp(0, __builtin_bit_cast(int, v), 0x114, 0xf, 0xf, true));
    v += __builtin_bit_cast(float, __builtin_amdgcn_update_dpp(0, __builtin_bit_cast(int, v), 0x118, 0xf, 0xf, true));
    v += __builtin_bit_cast(float, __builtin_amdgcn_update_dpp(0, __builtin_bit_cast(int, v), 0x142, 0xa, 0xf, false));
    v += __builtin_bit_cast(float, __builtin_amdgcn_update_dpp(0, __builtin_bit_cast(int, v), 0x143, 0xc, 0xf, false));
    return v;
}
__device__ __forceinline__ void gla_prep(Frame& F, int l) {
    const bf16* P = WSP(bf16, WS_PROJ); const f32x2* rope = WSP(f32x2, WS_ROPE);
    LAS unsigned char* L = F.lds;
    constexpr int L_QE0 = 0, L_KE0 = 17408, L_VT = 69632, L_P = 106496;
    const int lane = F.lane, w = F.wave, g = lane >> 4, lr = lane & 15;
    v4u pf[12];
#define GLA_PREP_LOAD(it_) do { const int ck_ = (it_) % 68, bh_ = (it_) / 68, h_ = bh_ & 3, b_ = bh_ >> 2; const int r0_ = ck_ < 4 ? TL + b_ * CTX + 64 * ck_ : b_ * SEQ + 64 * (ck_ - 4); \
        const bf16* pr0_ = P + (size_t)r0_ * NPROJ; \
        _Pragma("unroll") for (int i_ = 0; i_ < 4; ++i_) { const int p_ = F.tid + 512 * i_; pf[i_] = __builtin_nontemporal_load((const GAS v4u*)(pr0_ + (size_t)(p_ >> 5) * NPROJ + PC_GV + h_ * 256 + 8 * (p_ & 31))); } \
        _Pragma("unroll") for (int i_ = 0; i_ < 2; ++i_) { const int p_ = F.tid + 512 * i_; const bf16* rp_ = pr0_ + (size_t)(p_ >> 4) * NPROJ + h_ * 128 + 8 * (p_ & 15); \
            pf[4 + i_] = __builtin_nontemporal_load((const GAS v4u*)(rp_ + PC_GQ)); pf[6 + i_] = __builtin_nontemporal_load((const GAS v4u*)(rp_ + PC_GK)); pf[8 + i_] = __builtin_nontemporal_load((const GAS v4u*)(rp_ + PC_ZF)); pf[10 + i_] = __builtin_nontemporal_load((const GAS v4u*)(rp_ + PC_ZB)); } } while (0)
    constexpr int L_ROPE = 115712, L_GBL = L_ROPE + 64 * 272;
    { f32x2 rv_[4]; float gv_[2];
#pragma unroll
      for (int k = 0; k < 4; ++k) rv_[k] = ((const GAS f32x2*)rope)[F.tid + 512 * k];
#pragma unroll
      for (int k = 0; k < 2; ++k) gv_[k] = ((const GAS float*)(F.in[I_GB] + (size_t)l * 1024))[F.tid + 512 * k];
#pragma unroll
      for (int k = 0; k < 4; ++k) { const int i = F.tid + 512 * k; *(LAS f32x2*)(L + L_ROPE + (i >> 5) * 272 + (i & 31) * 8) = rv_[k]; }
#pragma unroll
      for (int k = 0; k < 2; ++k) ((LAS float*)(L + L_GBL))[F.tid + 512 * k] = gv_[k]; }
    if (F.bx < 1088) GLA_PREP_LOAD(F.bx);
    __syncthreads();
    for (int item = F.bx; item < 1088; item += F.G) {
        const int ck = item % 68, bh = item / 68, h = bh & 3, b = bh >> 2;
        const bool isctx = ck < 4;
        const int row0 = isctx ? TL + b * CTX + 64 * ck : b * SEQ + 64 * (ck - 4);
        unsigned char* gblk0 = F.ws + WS_GBLK + (size_t)((bh * 2 + 0) * 68 + ck) * GB_BYTES;
#pragma unroll
        for (int i = 0; i < 4; ++i) { const int p = F.tid + 512 * i; *(LAS v4u*)(L + (p >> 5) * 528 + 16 * (p & 31)) = pf[i]; }
#pragma unroll
        for (int i = 0; i < 2; ++i) { const int p = F.tid + 512 * i; const int o = (p >> 4) * 272 + 16 * (p & 15);
            *(LAS v4u*)(L + L_VT + o) = pf[4 + i]; *(LAS v4u*)(L + L_VT + 17408 + o) = pf[6 + i]; *(LAS v4u*)(L + 34816 + o) = pf[8 + i]; *(LAS v4u*)(L + 52224 + o) = pf[10 + i]; }
        { const int nitem = item + F.G; if (nitem < 1088) GLA_PREP_LOAD(nitem); }
        __syncthreads();
        float qv[16], kv[16]; v4u vraw[4], zraw[4];
        { const LAS v4u* qp = (const LAS v4u*)(L + L_VT + lane * 272 + 32 * w); const LAS v4u* kp = (const LAS v4u*)(L + L_VT + 17408 + lane * 272 + 32 * w);
          unpack8(qp[0], qv); unpack8(qp[1], qv + 8); unpack8(kp[0], kv); unpack8(kp[1], kv + 8);
          const LAS v4u* zf = (const LAS v4u*)(L + 34816 + lane * 272 + 32 * w); const LAS v4u* zb = (const LAS v4u*)(L + 52224 + lane * 272 + 32 * w);
          zraw[0] = zf[0]; zraw[1] = zf[1]; zraw[2] = zb[0]; zraw[3] = zb[1];
#pragma unroll
          for (int c4 = 0; c4 < 4; ++c4) vraw[c4] = *(const LAS v4u*)(L + lane * 528 + 64 * w + 16 * c4); }
        if (!isctx) {
            float qq[16], kk[16];
            { const LAS v4u* qp = (const LAS v4u*)(L + L_VT + lane * 272 + 32 * (w ^ 2)); const LAS v4u* kp = (const LAS v4u*)(L + L_VT + 17408 + lane * 272 + 32 * (w ^ 2));
              unpack8(qp[0], qq); unpack8(qp[1], qq + 8); unpack8(kp[0], kk); unpack8(kp[1], kk + 8); }
            const int s = 64 * (ck - 4) + lane; const int pos = (w >= 4) ? (s & 63) : (s >> 6); const bool second = ((w >> 1) & 1) != 0;
#pragma unroll
            for (int i = 0; i < 16; ++i) { const f32x2 cs = *(const LAS f32x2*)(L + L_ROPE + pos * 272 + (16 * (w & 1) + i) * 8);
                if (second) { qv[i] = qq[i] * cs.y + qv[i] * cs.x; kv[i] = kk[i] * cs.y + kv[i] * cs.x; }
                else { qv[i] = qv[i] * cs.x - qq[i] * cs.y; kv[i] = kv[i] * cs.x - kk[i] * cs.y; } }
        }
#pragma unroll
        for (int i = 0; i < 16; ++i) qv[i] *= 0.08838834764831845f;
        __syncthreads();
#pragma unroll
        for (int dir = 0; dir < 2; ++dir) {
            float lg[16], own[16];
            unpack8(zraw[2 * dir], lg); unpack8(zraw[2 * dir + 1], lg + 8);
            const LAS float* gbias = (const LAS float*)(L + L_GBL) + dir * 512 + h * 128 + 16 * w;
#pragma unroll
            for (int i = 0; i < 16; ++i) { const float z2 = (lg[i] + gbias[i]) * 1.4426950408889634f;
                lg[i] = -(fmaxf(-z2, 0.f) + __builtin_amdgcn_logf(1.0f + __builtin_amdgcn_exp2f(-fabsf(z2)))) * 0.0625f; own[i] = lg[i]; }
#pragma unroll
            for (int i = 0; i < 16; ++i) lg[i] = dpp_scan64(lg[i]);
            float tot[16];
#pragma unroll
            for (int i = 0; i < 16; ++i) tot[i] = __int_as_float(__builtin_amdgcn_readlane(__float_as_int(lg[i]), 63));
            if (dir) {
#pragma unroll
                for (int i = 0; i < 16; ++i) lg[i] = tot[i] - lg[i] + own[i];
            }
            float dect[16];
#pragma unroll
            for (int i = 0; i < 16; ++i) dect[i] = __builtin_amdgcn_exp2f(tot[i]);
            unsigned char* gblk = gblk0 + (size_t)dir * 68 * GB_BYTES;
            LAS unsigned char* qe_t = L + L_QE0 + dir * 34816 + lane * 272 + (32 * (w >> 1) + 4 * (w & 1)) * 2;
            LAS unsigned char* ke_t = L + L_KE0 + dir * 34816 + lane * 272 + (32 * (w >> 1) + 4 * (w & 1)) * 2;
            bf16* kdt = (bf16*)(gblk + GB_KDT) + lane;
#pragma unroll
            for (int gg = 0; gg < 4; ++gg) {
                float qe[4], ke[4];
#pragma unroll
                for (int j = 0; j < 4; ++j) { const int i = 4 * gg + j; const float eb = __builtin_amdgcn_exp2f(lg[i]); qe[j] = qv[i] * eb; ke[j] = kv[i] * __builtin_amdgcn_rcpf(eb);
                    kdt[(16 * w + i) * 72] = f2bf1(ke[j] * dect[i]); }
                v2u a; a.x = cvt_pk_bf16(qe[0], qe[1]); a.y = cvt_pk_bf16(qe[2], qe[3]); *(LAS v2u*)(qe_t + 16 * gg) = a;
                v2u c; c.x = cvt_pk_bf16(ke[0], ke[1]); c.y = cvt_pk_bf16(ke[2], ke[3]); *(LAS v2u*)(ke_t + 16 * gg) = c;
            }
            if (lane == 0) { float* dp = (float*)(gblk + GB_DEC) + 16 * w;
#pragma unroll
                for (int i4 = 0; i4 < 4; ++i4) *(f32x4*)(dp + 4 * i4) = (f32x4){dect[4 * i4], dect[4 * i4 + 1], dect[4 * i4 + 2], dect[4 * i4 + 3]}; }
        }
        { LAS unsigned char* vt = L + L_VT + 2 * (lane & ~1); const bool odd = (lane & 1) != 0;
#pragma unroll
          for (int c4 = 0; c4 < 4; ++c4) { const v4u x = vraw[c4]; const int v0 = 32 * w + 8 * c4;
#pragma unroll
              for (int m = 0; m < 4; ++m) { const unsigned xm = m == 0 ? x.x : (m == 1 ? x.y : (m == 2 ? x.z : x.w)); const unsigned ym = (unsigned)__shfl_xor((int)xm, 1);
                  const unsigned out = odd ? ((ym >> 16) | (xm & 0xffff0000u)) : ((xm & 0xffffu) | (ym << 16));
                  *(LAS unsigned*)(vt + (v0 + 2 * m + (odd ? 1 : 0)) * 144) = out; } } }
        __syncthreads();
        { const int tt = w >> 1, st0 = (w & 1) * 2;
          f32x4 pacc[2] = {(f32x4){0.f, 0.f, 0.f, 0.f}, (f32x4){0.f, 0.f, 0.f, 0.f}};
#pragma unroll
          for (int dir = 0; dir < 2; ++dir)
#pragma unroll
              for (int sti = 0; sti < 2; ++sti) { f32x4 acc = (f32x4){0.f, 0.f, 0.f, 0.f};
#pragma unroll
                  for (int ks = 0; ks < 4; ++ks) { const bf16x8v a = *(const LAS bf16x8v*)(L + L_QE0 + dir * 34816 + (16 * tt + lr) * 272 + (32 * ks + 8 * g) * 2);
                      const bf16x8v bb = *(const LAS bf16x8v*)(L + L_KE0 + dir * 34816 + (16 * (st0 + sti) + lr) * 272 + (32 * ks + 8 * g) * 2); acc = MFMA16(a, bb, acc); }
#pragma unroll
                  for (int r = 0; r < 4; ++r) { const int t = 16 * tt + 4 * g + r, s = 16 * (st0 + sti) + lr; const bool keep = dir ? (s >= t) : (s <= t); pacc[sti][r] += keep ? acc[r] : 0.f; } }
          { const bool odd = (lane & 1) != 0;
#pragma unroll
            for (int sti = 0; sti < 2; ++sti) { float q[4];
#pragma unroll
                for (int r = 0; r < 4; ++r) q[r] = __shfl_xor(pacc[sti][r], 1);
#pragma unroll
                for (int rr = 0; rr < 2; ++rr) { const int r = 2 * rr + (odd ? 1 : 0); const float mine = odd ? (rr ? pacc[sti][3] : pacc[sti][1]) : (rr ? pacc[sti][2] : pacc[sti][0]), oth = odd ? (rr ? q[3] : q[1]) : (rr ? q[2] : q[0]);
                    const unsigned out = odd ? cvt_pk_bf16(oth, mine) : cvt_pk_bf16(mine, oth);
                    *(LAS unsigned*)(L + L_P + (16 * tt + 4 * g + r) * 144 + 2 * (16 * (st0 + sti) + (lr & ~1))) = out; } } }
#pragma unroll
          for (int dir = 0; dir < 2; ++dir)
              for (int c = F.tid; c < 1088; c += NWAVES * 64) *(v4u*)(gblk0 + (size_t)dir * 68 * GB_BYTES + GB_QE + 16 * c) = *(const LAS v4u*)(L + L_QE0 + dir * 34816 + 16 * c);
        }
        __syncthreads();
        { bf16* oi = WSP(bf16, WS_OINTRA);
#pragma unroll
          for (int vti = 0; vti < 2; ++vti) { const int vt = 2 * w + vti;
#pragma unroll
              for (int tt = 0; tt < 4; ++tt) { f32x4 acc = (f32x4){0.f, 0.f, 0.f, 0.f};
#pragma unroll
                  for (int ks = 0; ks < 2; ++ks) { const bf16x8v a = *(const LAS bf16x8v*)(L + L_VT + (16 * vt + lr) * 144 + (32 * ks + 8 * g) * 2);
                      const bf16x8v bb = *(const LAS bf16x8v*)(L + L_P + (16 * tt + lr) * 144 + (32 * ks + 8 * g) * 2); acc = MFMA16(a, bb, acc); }
                  *(v2u*)(oi + (size_t)(row0 + 16 * tt + lr) * D + h * 256 + 16 * vt + 4 * g) = pack4(acc); } }
          unsigned char* vtb = F.ws + WS_VTB + (size_t)(bh * 68 + ck) * VT_BYTES;
          for (int c = F.tid; c < 2304; c += NWAVES * 64) *(v4u*)(vtb + 16 * c) = *(const LAS v4u*)(L + L_VT + 16 * c);
        }
        __syncthreads();
    }
}
template <int CTRL> __device__ __forceinline__ float dppf(float v) { return __builtin_bit_cast(float, __builtin_amdgcn_update_dpp(0, __builtin_bit_cast(int, v), CTRL, 0xf, 0xf, false)); }
__device__ __forceinline__ void gla_chain(Frame& F, int l, int chain, int vq) {
    const int b = chain >> 3, h = (chain >> 1) & 3, dir = chain & 1, bh = b * 4 + h;
    const int lane = F.lane, w = F.wave, g = lane >> 4, lr = lane & 15, vt = w & 3, hh = w >> 2;
    LAS unsigned char* L = F.lds;
    constexpr int BUF = 46080;
    bf16* OI = WSP(bf16, dir ? WS_OIB : WS_OIF);
    const unsigned char* gb_base = F.ws + WS_GBLK + (size_t)((bh * 2 + dir) * 68) * GB_BYTES;
    const unsigned char* vt_base = F.ws + WS_VTB + (size_t)(bh * 68) * VT_BYTES + (size_t)vq * 9216;
    f32x4 S[8];
#pragma unroll
    for (int i = 0; i < 8; ++i) S[i] = (f32x4){0.f, 0.f, 0.f, 0.f};
#define CHAIN_CK(step) (dir ? ((step) < 4 ? 3 - (step) : 71 - (step)) : (step))
#define CHAIN_LOAD(step, boff) do { const int ck_ = CHAIN_CK(step); const unsigned char* gsrc = gb_base + (size_t)ck_ * GB_BYTES; const unsigned char* vsrc = vt_base + (size_t)ck_ * VT_BYTES; \
        _Pragma("unroll") for (int i_ = 0; i_ < 6; ++i_) { const int c_ = w + 8 * i_; if (c_ < 45) { const unsigned char* src = (c_ < 36 ? gsrc + 1024 * c_ : vsrc + 1024 * (c_ - 36)) + 16 * lane; \
            __builtin_amdgcn_global_load_lds((const unsigned*)src, (LAS unsigned*)(L + (boff) + 1024 * c_), 16, 0, 0); } } } while (0)
    CHAIN_LOAD(0, 0); CHAIN_LOAD(1, BUF);
    int cb = 0, nb2 = 2 * BUF;
    for (int step = 0; step < 68; ++step) {
        if (step + 1 < 68) { if (w < 5) asm volatile("s_waitcnt vmcnt(6)" ::: "memory"); else asm volatile("s_waitcnt vmcnt(5)" ::: "memory"); }
        else asm volatile("s_waitcnt vmcnt(0)" ::: "memory");
        __builtin_amdgcn_s_barrier(); asm volatile("" ::: "memory");
        const LAS unsigned char* cur = L + cb;
        const int ck = CHAIN_CK(step);
        const int row0 = ck < 4 ? TL + b * CTX + 64 * ck : b * SEQ + 64 * (ck - 4);
        bf16x8v sa[4];
#pragma unroll
        for (int s = 0; s < 4; ++s) { v4u u; u.x = cvt_pk_bf16(S[2 * s][0], S[2 * s][1]); u.y = cvt_pk_bf16(S[2 * s][2], S[2 * s][3]); u.z = cvt_pk_bf16(S[2 * s + 1][0], S[2 * s + 1][1]); u.w = cvt_pk_bf16(S[2 * s + 1][2], S[2 * s + 1][3]);
            sa[s] = __builtin_bit_cast(bf16x8v, u); }
#pragma unroll
        for (int tti = 0; tti < 2; ++tti) { const int tt = 2 * hh + tti; f32x4 acc = (f32x4){0.f, 0.f, 0.f, 0.f};
#pragma unroll
            for (int s = 0; s < 4; ++s) { const bf16x8v bb = *(const LAS bf16x8v*)(cur + GB_QE + (16 * tt + lr) * 272 + (32 * s + 8 * g) * 2); acc = MFMA16(sa[s], bb, acc); }
            *(v2u*)(OI + (size_t)(row0 + 16 * tt + lr) * D + h * 256 + 64 * vq + 16 * vt + 4 * g) = pack4(acc); }
        if (step + 2 < 68) CHAIN_LOAD(step + 2, nb2);
        cb = cb + BUF == 3 * BUF ? 0 : cb + BUF; nb2 = nb2 + BUF == 3 * BUF ? 0 : nb2 + BUF;
        const LAS float* dl = (const LAS float*)(cur + GB_DEC) + 16 * (lr >> 2) + 4 * g + (lr & 3); const float D0 = dl[0], D1 = dl[64];
#define CHAIN_UPD(dt) do { f32x4 acc; const float dsel_ = (dt) < 4 ? D0 : D1; \
            acc[0] = S[dt][0] * dppf<0x150 + 4 * ((dt) & 3) + 0>(dsel_); acc[1] = S[dt][1] * dppf<0x150 + 4 * ((dt) & 3) + 1>(dsel_);        \
            acc[2] = S[dt][2] * dppf<0x150 + 4 * ((dt) & 3) + 2>(dsel_); acc[3] = S[dt][3] * dppf<0x150 + 4 * ((dt) & 3) + 3>(dsel_); \
            _Pragma("unroll") for (int ks = 0; ks < 2; ++ks) { const bf16x8v a = *(const LAS bf16x8v*)(cur + GB_KDT + (16 * (dt) + lr) * 144 + (32 * ks + 8 * g) * 2); \
                const bf16x8v bb = *(const LAS bf16x8v*)(cur + GB_BYTES + (16 * vt + lr) * 144 + (32 * ks + 8 * g) * 2); acc = MFMA16(a, bb, acc); } \
            S[dt] = acc; } while (0)
        CHAIN_UPD(0); CHAIN_UPD(1); CHAIN_UPD(2); CHAIN_UPD(3); CHAIN_UPD(4); CHAIN_UPD(5); CHAIN_UPD(6); CHAIN_UPD(7);
#undef CHAIN_UPD
    }
    asm volatile("s_waitcnt vmcnt(0)" ::: "memory"); __builtin_amdgcn_s_barrier();
#undef CHAIN_CK
#undef CHAIN_LOAD
}
__device__ __forceinline__ void nat_relayout(Frame& F) {
    const bf16* P = WSP(bf16, WS_PROJ); bf16* NK = WSP(bf16, WS_NK); bf16* NVT = WSP(bf16, WS_NVT);
    if (F.bx < 64 && F.G > 64) return;
    const int nlo = F.G > 64 ? 64 : 0; const int gw = (F.bx - nlo) * NWAVES + F.wave, NGW = (F.G - nlo) * NWAVES, lane = F.lane;
    for (int it = gw; it < (T / 8) * 8; it += NGW) {
        const int h = it & 7, blk = it >> 3;
        { const int j = lane >> 3, ch = lane & 7;
          *(v4u*)(NK + ((size_t)h * T + 8 * blk + j) * 64 + 8 * ch) = *(const v4u*)(P + (size_t)(8 * blk + j) * NPROJ + PC_NK + h * 64 + 8 * ch); }
        { const bf16* vp = P + (size_t)(8 * blk) * NPROJ + PC_NV + h * 64 + lane; unsigned x[4];
#pragma unroll
          for (int j2 = 0; j2 < 4; ++j2) x[j2] = (unsigned)vp[(size_t)(2 * j2) * NPROJ] | ((unsigned)vp[(size_t)(2 * j2 + 1) * NPROJ] << 16);
          *(v4u*)(NVT + (((size_t)h * (T / 8) + blk) * 64 + lane) * 8) = (v4u){x[0], x[1], x[2], x[3]}; }
    }
}
typedef short v4i16_t __attribute__((ext_vector_type(4)));
__device__ __forceinline__ v2u vtr64(const LAS unsigned char* p) { return __builtin_bit_cast(v2u, __builtin_amdgcn_ds_read_tr16_b64_v4i16((LAS v4i16_t*)p)); }
constexpr int CW_NATQ = 8192;
__device__ __forceinline__ void nat_wg(Frame& F, int l, volatile LAS unsigned* bcast, bool single) {
    const bf16* P = WSP(bf16, WS_PROJ); const bf16* NK = WSP(bf16, WS_NK); const bf16* NVT = WSP(bf16, WS_NVT); bf16* YN = WSP(bf16, WS_YN);
    unsigned* ctr = (unsigned*)(F.ws + WS_CTL) + CW_NATQ + 64 * l;
    LAS unsigned char* L = F.lds;
    constexpr int L_KB = 0, L_VB = 69120, L_RP = 131584, L_KC = 0, L_VC = 36864, VBP = 976, VCP = 528;
    const int w = F.wave;
    const int NSU = 1024 + (l == DEPTH - 1 ? 0 : 64);
    unsigned nxt_su = 0; if (F.tid == 0) nxt_su = __hip_atomic_fetch_add(ctr, 1u, __ATOMIC_RELAXED, __HIP_MEMORY_SCOPE_AGENT);
    for (;;) {
        int tid = F.tid; asm volatile("" : "+v"(tid));
        const int lane = tid & 63, g = lane >> 4, lr = lane & 15;
        if (tid == 0) { bcast[0] = nxt_su; if (!single && (int)nxt_su < NSU) nxt_su = __hip_atomic_fetch_add(ctr, 1u, __ATOMIC_RELAXED, __HIP_MEMORY_SCOPE_AGENT); else nxt_su = 0x7fffffffu; }
        __syncthreads();
        const int su = (int)bcast[0];
        if (su >= NSU) break;
        const bool lat = su < 1024;
        int b, h, nb = 0, r0 = 0, qrow0;
        if (lat) { const int rg = su & 7; nb = (su >> 3) & 3; h = (su >> 5) & 7; b = su >> 8; r0 = 8 * rg; qrow0 = b * SEQ + (r0 + w) * 64 + 16 * nb; }
        else { const int cu = su - 1024; h = (cu >> 1) & 7; b = cu >> 4; qrow0 = TL + b * CTX + 16 * (8 * (cu & 1) + w); }
        const bf16* NVh = NVT + (size_t)h * (T / 8) * 512;
        const int kr0 = min(max(r0 - 4, 0), 56), nrows = min(max(r0 + 3, 0), 56) + 8 - kr0;
        const int bs = nb == 0 ? 0 : (nb == 1 ? 8 : (nb == 2 ? 24 : 32));
        if (lat) {
            const int nkp = nrows * 256;
            { const int nkb = nrows * 4;
#pragma unroll
              for (int i = 0; i < 8; ++i) { const int blk = w + 8 * i; if (blk < nkb) { const int key = 8 * blk + (lane >> 3); const int grow = b * SEQ + (kr0 + (key >> 5)) * 64 + bs + (key & 31);
                  const bf16* src = P + (size_t)grow * NPROJ + PC_NK + h * 64 + 8 * ((lane & 7) ^ ((key >> 1) & 7));
                  __builtin_amdgcn_global_load_lds((const unsigned*)src, (LAS unsigned*)(L + L_KB + 1024 * blk), 16, 0, 0); } } }
            { const int nkb = nrows * 4;
#pragma unroll
              for (int i = 0; i < 8; ++i) { const int blk = w + 8 * i; if (blk < nkb) { const int key = 8 * blk + (lane >> 3); const int grow = b * SEQ + (kr0 + (key >> 5)) * 64 + bs + (key & 31);
                  const bf16* src = P + (size_t)grow * NPROJ + PC_NV + h * 64 + 8 * ((lane & 7) ^ (((key >> 1) & 3) << 1));
                  __builtin_amdgcn_global_load_lds((const unsigned*)src, (LAS unsigned*)(L + L_VB + 1024 * blk), 16, 0, 0); } } }
            if (tid < 465) ((LAS float*)(L + L_RP))[tid] = F.in[I_RPB][(size_t)(l * 8 + h) * 465 + tid] * 1.4426950408889634f;
        }
        asm volatile("s_waitcnt vmcnt(0)" ::: "memory");
        __syncthreads();
        bf16x8v bq[2];
#pragma unroll
        for (int ks = 0; ks < 2; ++ks) bq[ks] = *(const GAS bf16x8v*)(P + (size_t)(qrow0 + lr) * NPROJ + PC_NQ + h * 64 + 32 * ks + 8 * g);
        v4u kreg[4], vreg[4];
#pragma unroll
        for (int i = 0; i < 4; ++i) { const int p = tid + 512 * i; kreg[i] = *(const GAS v4u*)(P + (size_t)(TL + b * CTX + (p >> 3)) * NPROJ + PC_NK + h * 64 + 8 * (p & 7));
            vreg[i] = *(const GAS v4u*)(P + (size_t)(TL + b * CTX + (p >> 3)) * NPROJ + PC_NV + h * 64 + 8 * (p & 7)); }
        f32x4 O[4];
#pragma unroll
        for (int dt = 0; dt < 4; ++dt) O[dt] = (f32x4){0.f, 0.f, 0.f, 0.f};
        float m = -1.0e30f, lsum = 0.f;
        const int r = r0 + w, rs = min(max(r - 4, 0), 56), lb = rs - kr0;
        const int c = 16 * nb + lr, cs = min(max(c - 8, 0), 48);
        constexpr float QS = 0.125f * 1.4426950408889634f;
        bool vm[2][4];
#pragma unroll
        for (int k1 = 0; k1 < 2; ++k1)
#pragma unroll
            for (int e = 0; e < 4; ++e) vm[k1][e] = (unsigned)(bs + 16 * k1 + 4 * g + e - cs) < 16u;
        const int vrow = (4 * g + (lr >> 2)) * 128 + 8 * (lr & 1), vx = ((2 * g + (lr >> 3)) & 3) << 1;
        const LAS float* Rb = (const LAS float*)(L + L_RP) + (rs - r + 7) * 31 + 15 - c + bs + 4 * g;
#pragma unroll
        for (int qt = 0; qt < 4; ++qt) {
            const int half = qt >> 1, sub = qt & 1;
            if (half == 0 && !lat) continue;
            if (qt == 2) {
                __syncthreads();
#pragma unroll
                for (int i = 0; i < 4; ++i) { const int p = tid + 512 * i; *(LAS v4u*)(L + L_KC + (p >> 3) * 144 + 16 * (p & 7)) = kreg[i]; *(LAS v4u*)(L + L_VC + (p >> 3) * 128 + 16 * ((p & 7) ^ ((((p >> 3) >> 1) & 3) << 1))) = vreg[i]; }
                __syncthreads();
            }
            f32x4 s[8];
#pragma unroll
            for (int k8 = 0; k8 < 8; ++k8) { const int kt = 8 * sub + k8;
                f32x4 acc = (f32x4){0.f, 0.f, 0.f, 0.f};
                __builtin_amdgcn_s_setprio(1);
#pragma unroll
                for (int ks = 0; ks < 2; ++ks) {
                    const LAS unsigned char* kp = half == 0 ? L + L_KB + (32 * (lb + (kt >> 1)) + 16 * (kt & 1) + lr) * 128 + (((4 * ks + g) ^ (lr >> 1)) * 16) : L + L_KC + (16 * kt + lr) * 144 + (32 * ks + 8 * g) * 2;
                    const bf16x8v ak = *(const LAS bf16x8v*)kp; acc = MFMA16(ak, bq[ks], acc); }
                __builtin_amdgcn_s_setprio(0);
                if (half == 0) {
#pragma unroll
                    for (int e = 0; e < 4; ++e) acc[e] = vm[kt & 1][e] ? __builtin_fmaf(acc[e], QS, Rb[31 * (kt >> 1) + 16 * (kt & 1) + e]) : -1.0e30f; }
                s[k8] = acc;
            }
            float mx = -1.0e30f;
#pragma unroll
            for (int k8 = 0; k8 < 8; ++k8) mx = fmaxf(fmaxf(fmaxf(mx, s[k8][0]), fmaxf(s[k8][1], s[k8][2])), s[k8][3]);
            if (half == 1) mx *= QS;
            mx = fmaxf(mx, __shfl_xor(mx, 16)); mx = fmaxf(mx, __shfl_xor(mx, 32));
            const float m2 = fmaxf(m, mx), sc = __builtin_amdgcn_exp2f(m - m2); m = m2; lsum *= sc;
#pragma unroll
            for (int dt = 0; dt < 4; ++dt) O[dt] = O[dt] * sc;
            float ps = 0.f;
#pragma unroll
            for (int k8 = 0; k8 < 8; ++k8)
#pragma unroll
                for (int e = 0; e < 4; ++e) { const float p = __builtin_amdgcn_exp2f(half == 0 ? s[k8][e] - m2 : __builtin_fmaf(s[k8][e], QS, -m2)); s[k8][e] = p; ps += p; }
            lsum += ps;
#pragma unroll
            for (int k4 = 0; k4 < 4; ++k4) {
                const int k2 = 4 * sub + k4;
                v4u pu; pu.x = cvt_pk_bf16(s[2 * k4][0], s[2 * k4][1]); pu.y = cvt_pk_bf16(s[2 * k4][2], s[2 * k4][3]); pu.z = cvt_pk_bf16(s[2 * k4 + 1][0], s[2 * k4 + 1][1]); pu.w = cvt_pk_bf16(s[2 * k4 + 1][2], s[2 * k4 + 1][3]);
                const bf16x8v pb = __builtin_bit_cast(bf16x8v, pu);
                __builtin_amdgcn_s_setprio(1);
                const LAS unsigned char* vp = (half == 0 ? L + L_VB + (32 * (lb + k2)) * 128 : L + L_VC + (32 * k2) * 128) + vrow;
#pragma unroll
                for (int dt = 0; dt < 4; ++dt) {
                    const LAS unsigned char* va_p = vp + 16 * ((2 * dt + (lr >> 1 & 1)) ^ vx);
                    const v2u va = vtr64(va_p), vb = vtr64(va_p + 16 * 128);
                    const bf16x8v av = __builtin_bit_cast(bf16x8v, (v4u){va.x, va.y, vb.x, vb.y});
                    O[dt] = MFMA16(av, pb, O[dt]);
                }
                __builtin_amdgcn_s_setprio(0);
            }
        }
        lsum += __shfl_xor(lsum, 16); lsum += __shfl_xor(lsum, 32);
        const float inv = 1.0f / lsum;
#pragma unroll
        for (int dt = 0; dt < 4; ++dt) *(v2u*)(YN + (size_t)(qrow0 + lr) * 512 + h * 64 + 16 * dt + 4 * g) = pack4(O[dt] * inv);
    }
}

constexpr int NPL = 11, NPHASES = 2 + DEPTH * NPL;
struct Args { const float* in[N_IN]; float* out; unsigned char* ws; int ph_lo, ph_hi; };
static_assert(sizeof(Args) == N_IN * 8 + 8 + 8 + 8, "Args has no padding");
__global__ void __launch_bounds__(NWAVES * 64, 2) fwd_kernel(Args args) {
    extern __shared__ __attribute__((aligned(16))) unsigned char lds_raw[];
    Frame F;
    F.lds = (LAS unsigned char*)lds_raw;
    F.tid = otid(); F.lane = F.tid & 63; F.wave = __builtin_amdgcn_readfirstlane(F.tid >> 6);
    F.G = gridDim.x; F.bx = blockIdx.x; F.ws = args.ws; F.out = args.out;
    { KIN inp = (KIN)__builtin_amdgcn_kernarg_segment_ptr(); asm volatile("" : "+s"(inp)); F.in = inp; }
    volatile LAS unsigned* MISC = (volatile LAS unsigned*)(F.lds + MISC_OFF);
    for (int u = F.tid; u < (LDS_BYTES - LDSCTL_OFF) / 4; u += NWAVES * 64) ((LAS unsigned*)(F.lds + LDSCTL_OFF))[u] = 0u;
    __syncthreads();
    XcdBarrier bar; bar.bar = (unsigned*)(args.ws + WS_CTL) + CW_BAR; bar.x = 0; bar.st = nullptr;
    if (!MK_MULTI) bar = xcd_barrier_post((unsigned*)(args.ws + WS_CTL) + CW_BAR, MISC + 8);
    const int lo = args.ph_lo, hi = args.ph_hi;
#define IN(k) (lo <= (k) && (k) < hi)
#define RETID() do { F.tid = otid(); F.lane = F.tid & 63; F.wave = __builtin_amdgcn_readfirstlane(F.tid >> 6); asm volatile("" : "+s"(F.ws), "+s"(F.out), "+s"(F.in)); } while (0)
#define SEAM(k) do { if (!MK_MULTI && (k) + 1 < hi) xcd_barrier<false>(bar); } while (0)
#define SEAM0() do { if (!MK_MULTI && 1 < hi) xcd_barrier<true>(bar); } while (0)
    using namespace pg8;
    LAS unsigned char* ring = F.lds;

#ifndef NO_G0
    if (IN(0)) { phase_g0(F); SEAM0(); }
#endif
    if (SITE_THIN && IN(1)) { phase_g1(F); SEAM(1); }
    for (int l = 0; l < DEPTH; ++l) {
        const int base = 2 + l * NPL; const bool moe = (l & 1) != 0;
        if (SITE_PROJ && IN(base + 0)) { RETID();
            Gemm g{WSP(bf16, WS_H), WSP(bf16, WS_WIN) + (size_t)l * NPROJ * D, T, NPROJ, D}; StaticOrder S; S.init(T, NPROJ, F.G, F.bx);
            EpiProj E{WSP(bf16, WS_PROJ), NPROJ, WSP(bf16, WS_NVT), -1000, T / 8};
            gemm_phase<EpiProj, StaticOrder, PG8_ALIGN, PG8_SP2>(ring, g, S, E);
            SEAM(base + 0);
        }
        if (IN(base + 1)) { RETID();
#ifndef NO_PREP
            gla_prep(F, l);
#endif
#ifndef NO_NATWG
            if (F.bx >= 64) nat_wg(F, l, MISC + 16, true);
#endif
            SEAM(base + 1); }
        if (IN(base + 2)) { RETID();
#ifndef NO_CHAIN
            if (F.bx < 128) gla_chain(F, l, F.bx & 31, F.bx >> 5);
#endif
#ifndef NO_NATWG
            nat_wg(F, l, MISC + 16, false);
#endif
            SEAM(base + 2);
        }
        if (SITE_THIN && IN(base + 3)) { RETID(); phase_gla_out(F, l); SEAM(base + 3); }
        if (SITE_BR && IN(base + 4)) { RETID();
            const int nctx1 = l == DEPTH - 1 ? 0 : 32, nctx2 = l == DEPTH - 1 ? 0 : 16;
            { Gemm g{WSP(bf16, WS_YG), WSP(bf16, WS_WBG) + (size_t)l * D * D, TROWS(l), D, D}; BranchOrder S; S.init(TL, F.G, F.bx, 0, nctx1, 2, 512);
              EpiGateBr<false, false> E{WSP(bf16, WS_MB), D, WSP(bf16, WS_PROJ) + PC_GA, NPROJ, WSP(bf16, WS_MB3)};
              gemm_phase<EpiGateBr<false, false>, BranchOrder, PG8_ALIGN, PG8_SP2>(ring, g, S, E); }
            VM_WAIT(); __syncthreads();
            { Gemm g{WSP(bf16, WS_YN), WSP(bf16, WS_WBN) + (size_t)l * D * 512, TROWS(l), D, 512}; BranchOrder S; S.init(TL, F.G, F.bx, 32, nctx2, 1, 512);
              EpiGateBr<true, true> E{WSP(bf16, WS_MB), D, WSP(bf16, WS_PROJ) + PC_GB, NPROJ, WSP(bf16, WS_MB2)};
              gemm_phase<EpiGateBr<true, true>, BranchOrder, PG8_ALIGN, PG8_SP2>(ring, g, S, E); }
            SEAM(base + 4);
        }
        if (SITE_OUT && IN(base + 5)) { RETID();
            Gemm g{WSP(bf16, WS_MB), WSP(bf16, WS_WO) + (size_t)l * D * D, TROWS(l), D, D};
            { CtxSplit3Order S; S.init(TL, F.G, F.bx, (long)(WS_MB2 - WS_MB) - (long)TL * D * 2, (long)(WS_MB3 - WS_MB) - (long)TL * D * 2, l == DEPTH - 1 ? 0 : 192);
              EpiStoreSplit3 E{WSP(bf16, WS_Y), D, WSP(bf16, WS_YC)}; gemm_phase<EpiStoreSplit3, CtxSplit3Order, PG8_ALIGN, PG8_SP2>(ring, g, S, E); }
            SEAM(base + 5);
        }
        if (SITE_THIN && IN(base + 6)) { RETID(); phase_post_mix(F, l); SEAM(base + 6); }
        if (SITE_THIN && moe && IN(base + 7)) { RETID(); phase_moe_gather(F, l); SEAM(base + 7); }
        if (SITE_UP && IN(base + 8)) { RETID();
            EpiSwiGLU8 E{WSP(unsigned char, WS_HID), DFF};
            { int cnt[8] = {T, 0, 0, 0, 0, 0, 0, 0}; MoeOrder S; Gemm g;
              if (moe) { moe_counts(F, l >> 1, cnt); S.init(cnt, 28, (long)7168 * D * 2, F.G, F.bx); g = Gemm{WSP(bf16, WS_XG), WSP(bf16, WS_W13) + (size_t)(2 + (l >> 1) * 8) * 7168 * D, 0, 7168, D / 2}; }
              else { S.init(cnt, 28, 0L, F.G, F.bx); g = Gemm{WSP(bf16, WS_H), WSP(bf16, WS_W13) + (size_t)(l >> 1) * 7168 * D, T, 7168, D / 2}; }
              gemm_phase<EpiSwiGLU8, MoeOrder, PG8_ALIGN, PG8_SP2, true>(ring, g, S, E, 122, 127); }
            SEAM(base + 8);
        }
        if (SITE_DOWN && IN(base + 9)) { RETID();
            if (moe) { int cnt[8]; moe_counts(F, l >> 1, cnt); const int st = moe_split_tile(cnt, F.G); MoeOrder S; S.init(cnt, 4, (long)D * DFF * 2, F.G, F.bx, st, 7, 256);
                Gemm g{WSP(bf16, WS_HID), WSP(bf16, WS_W2) + (size_t)(2 + (l >> 1) * 8) * D * DFF, 0, D, DFF / 2};
                EpiMoeDown E{WSP(bf16, WS_FS), D, WSP(bf16, WS_XG), 512, st, (size_t)MOE_SL_ROWS * D};
                gemm_phase<EpiMoeDown, MoeOrder, PG8_ALIGN, PG8_SP2, true>(ring, g, S, E, 122, 127); }
#if DENSE_FP8
            else { Gemm g{WSP(bf16, WS_HID), WSP(bf16, WS_W2) + (size_t)(l >> 1) * D * DFF, T, D, DFF / 2}; CtxSplitOrder S; S.init(TL, DFF / 2, 256, F.G, F.bx);
                EpiStoreSplit E2{WSP(bf16, WS_FS), D, WSP(bf16, WS_FC), 512}; gemm_phase<EpiStoreSplit, CtxSplitOrder, PG8_ALIGN, PG8_SP2, true>(ring, g, S, E2, 122, 127); }
#else
            else { Gemm g{WSP(bf16, WS_HID), WSP(bf16, WS_W2) + (size_t)(l >> 1) * D * DFF, T, D, DFF}; CtxSplitOrder S; S.init(TL, DFF, 512, F.G, F.bx);
                EpiStoreSplit E2{WSP(bf16, WS_FS), D, WSP(bf16, WS_FC), 1024}; gemm_phase<EpiStoreSplit, CtxSplitOrder, PG8_ALIGN, PG8_SP2>(ring, g, S, E2); }
#endif
            SEAM(base + 9);
        }
        if (SITE_THIN && IN(base + 10)) { RETID(); phase_post_ffn(F, l); SEAM(base + 10); }
    }
#undef IN
#undef SEAM
}

static bool phase_applicable(int k) {
    if (k < 2) return true;
    const int l = (k - 2) / NPL, p = (k - 2) % NPL;
    if (p == 7) return (l & 1) != 0;
    return true;
}
extern "C" void kernel_launch(void* const* d_in, const int* in_sizes, int n_in, void* d_out, int out_size, void* d_ws, size_t ws_size, hipStream_t stream) {
    static int grid = 0;
    if (grid == 0) {
        if (n_in != N_IN || out_size != TL * D || ws_size < WS_END) { fprintf(stderr, "kernel_launch: unexpected shapes (n_in %d, out %d, ws %zu < %zu)\n", n_in, out_size, ws_size, (size_t)WS_END); grid = -1; return; }
        int dev = 0, cus = 0, per_cu = 0;
        if (hipGetDevice(&dev) != hipSuccess || hipDeviceGetAttribute(&cus, hipDeviceAttributeMultiprocessorCount, dev) != hipSuccess) { grid = -1; return; }
        if (hipFuncSetAttribute((const void*)fwd_kernel, hipFuncAttributeMaxDynamicSharedMemorySize, LDS_BYTES) != hipSuccess) { fprintf(stderr, "kernel_launch: hipFuncSetAttribute failed\n"); grid = -1; return; }
        if (hipOccupancyMaxActiveBlocksPerMultiprocessor(&per_cu, (const void*)fwd_kernel, NWAVES * 64, LDS_BYTES) != hipSuccess || per_cu < 1)
            fprintf(stderr, "kernel_launch: occupancy query reports %d blocks per CU\n", per_cu);
        (void)hipGetLastError();
        grid = cus;
    }
    if (grid < 0) return;
    if (hipMemsetAsync((char*)d_ws + WS_CTL, 0, CTL_ZERO_BYTES, stream) != hipSuccess) { fprintf(stderr, "kernel_launch: memset failed\n"); return; }
    Args a{};
    for (int i = 0; i < N_IN; ++i) a.in[i] = (const float*)d_in[i];
    a.out = (float*)d_out; a.ws = (unsigned char*)d_ws;
#if MK_MULTI
    for (int k = 0; k < NPHASES; ++k) { if (!phase_applicable(k)) continue; a.ph_lo = k; a.ph_hi = k + 1;
        hipLaunchKernelGGL(fwd_kernel, dim3(grid), dim3(NWAVES * 64), LDS_BYTES, stream, a); }
#else
    a.ph_lo = 0; a.ph_hi = NPHASES;
    hipLaunchKernelGGL(fwd_kernel, dim3(grid), dim3(NWAVES * 64), LDS_BYTES, stream, a);
#endif
    const hipError_t le = hipPeekAtLastError();
    if (le != hipSuccess) fprintf(stderr, "kernel_launch: launch failed: %s\n", hipGetErrorName(le));
}
```

```cpp
#include <hip/hip_runtime.h>
#include <cstdio>
#include <cstdint>
namespace pg8 {
#define PG8_LAS __attribute__((address_space(3)))
typedef unsigned short bf16_t;
typedef short bf16x8 __attribute__((ext_vector_type(8)));
typedef float f32x4 __attribute__((ext_vector_type(4)));
typedef unsigned u32x4 __attribute__((ext_vector_type(4)));
typedef int v8i_t __attribute__((ext_vector_type(8)));
constexpr int BM = 256, BK = 64, HALF = 128, HTB = HALF * BK * 2  , STAGE_BYTES = 8 * HTB, NXCD = 8, WGM = 4;

__host__ __device__ __forceinline__ int lds_byte(int r, int c) { const int st = (r >> 4) * 2 + (c >> 5), rr = r & 15, cc = c & 31, ob = rr * 64 + cc * 2; return st * 1024 + (ob ^ (((ob >> 9) & 1) << 5)); }
__host__ __device__ __forceinline__ void stage_rc(int b, int& R, int& C) { const int st = b / 1024, sb = b % 1024, swz = sb ^ (((sb >> 9) & 1) << 5); R = (st >> 1) * 16 + swz / 64; C = (st & 1) * 32 + (swz % 64) / 2; }
__host__ __device__ __forceinline__ int perm32(int rho) { const int n = rho >> 4, i = rho & 15; return 8 * (i >> 2) + 4 * n + (i & 3); }

struct Unit { int pm, pn; long boff; long koff; int nt; };
struct Gemm { const bf16_t* A; const bf16_t* Bt; int M, N, K; };

struct StaticOrder {
    int nM, nN, nwg, G, c;
    __host__ __device__ void init(int M, int N, int G_, int c_) { nM = M / BM; nN = N / BM; nwg = nM * nN; G = G_; c = c_; }
    __host__ __device__ bool next(int i, Unit& u) const {
        const long L = (long)i * G + c; if (L >= nwg) return false;
        int wgid = (int)L; { const int q = nwg / NXCD, r = nwg % NXCD, xcd = wgid % NXCD, off = wgid / NXCD; wgid = (xcd < r ? xcd * (q + 1) : r * (q + 1) + (xcd - r) * q) + off; }
        const int nig = WGM * nN, gid = wgid / nig, fm = gid * WGM, gsz = (nM - fm) < WGM ? (nM - fm) : WGM;
        u.pm = fm + ((wgid % nig) % gsz); u.pn = (wgid % nig) / gsz; u.boff = 0; u.koff = 0; u.nt = 0; return true;
    }
    __device__ __forceinline__ void a_ready(const Unit&) const {}
    __device__ __forceinline__ void done(const Unit&) const {}
};

typedef __bf16 bf16x2_t __attribute__((ext_vector_type(2)));
typedef float f32x2_t __attribute__((ext_vector_type(2)));
__device__ __forceinline__ unsigned cvt_pk_bf16(float lo, float hi) { const f32x2_t v = {lo, hi}; const bf16x2_t b = __builtin_convertvector(v, bf16x2_t); return __builtin_bit_cast(unsigned, b); }
typedef float f32x2 __attribute__((ext_vector_type(2)));
__device__ __forceinline__ f32x2 gelu_pk(f32x2 v) {
    const f32x2 av = __builtin_elementwise_abs(v), d = av * 0.2316418882f + 1.0f;
    f32x2 t; t.x = __builtin_amdgcn_rcpf(d.x); t.y = __builtin_amdgcn_rcpf(d.y);
    f32x2 q = t * 0.5307027145f + (-0.7265760135f); q = q * t + 0.7107068705f; q = q * t + (-0.142248368f); q = q * t + 0.127414796f; q = q * t;
    const f32x2 s = (v * v) * (-0.72134752044f);
    f32x2 e; e.x = __builtin_amdgcn_exp2f(s.x); e.y = __builtin_amdgcn_exp2f(s.y);
    const f32x2 m = v * (q * e), r = v - m;
    f32x2 o; o.x = v.x < 0.f ? m.x : r.x; o.y = v.y < 0.f ? m.y : r.y; return o;
}

__device__ __forceinline__ float bflo(unsigned w) { return __uint_as_float(w << 16); }
__device__ __forceinline__ float bfhi(unsigned w) { return __uint_as_float(w & 0xffff0000u); }
__device__ __forceinline__ float sigmoidf_(float x) { return __builtin_amdgcn_rcpf(1.0f + __expf(-x)); }
__device__ __forceinline__ unsigned pk4_fp8(float a, float b, float c, float d) {
    a = __builtin_amdgcn_fmed3f(a, -448.f, 448.f); b = __builtin_amdgcn_fmed3f(b, -448.f, 448.f); c = __builtin_amdgcn_fmed3f(c, -448.f, 448.f); d = __builtin_amdgcn_fmed3f(d, -448.f, 448.f);
    int w = 0; w = __builtin_amdgcn_cvt_pk_fp8_f32(a, b, w, false); w = __builtin_amdgcn_cvt_pk_fp8_f32(c, d, w, true); return (unsigned)w;
}
struct EpiStore {
    static constexpr bool PERM = true, AFTER_DRAIN = false;
    bf16_t* O; int ldc; int mrows;
    __device__ __forceinline__ void operator()(const f32x4 (&acc)[2][2][4][2], const Unit& u, int wr, int wc, int fr, int fq) const {
        const int row0 = u.pm * BM + wr * 64 + fr, col0 = u.pn * BM + wc * 32 + 8 * fq;
#pragma unroll
        for (int ai = 0; ai < 2; ++ai)
#pragma unroll
            for (int m = 0; m < 4; ++m) { const int row = row0 + ai * HALF + m * 16; if (row >= mrows) continue; bf16_t* rowp = O + (size_t)row * ldc + col0;
#pragma unroll
                for (int bj = 0; bj < 2; ++bj) { const f32x4 v0 = acc[ai][bj][m][0], v1 = acc[ai][bj][m][1];
                    u32x4 w; w.x = cvt_pk_bf16(v0[0], v0[1]); w.y = cvt_pk_bf16(v0[2], v0[3]); w.z = cvt_pk_bf16(v1[0], v1[1]); w.w = cvt_pk_bf16(v1[2], v1[3]);
                    *(u32x4*)(rowp + bj * HALF) = w; } }
    }
};
template <bool ACCUM> struct EpiGate {
    static constexpr bool PERM = true, AFTER_DRAIN = false;
    bf16_t* O; int ldc; const bf16_t* G; int ldg;
    __device__ __forceinline__ void operator()(const f32x4 (&acc)[2][2][4][2], const Unit& u, int wr, int wc, int fr, int fq) const {
        const int row0 = u.pm * BM + wr * 64 + fr, col0 = u.pn * BM + wc * 32 + 8 * fq;
#pragma unroll
        for (int ai = 0; ai < 2; ++ai)
#pragma unroll
            for (int m = 0; m < 4; ++m) { const int row = row0 + ai * HALF + m * 16; bf16_t* rowp = O + (size_t)row * ldc + col0; const bf16_t* gp = G + (size_t)row * ldg + col0;
#pragma unroll
                for (int bj = 0; bj < 2; ++bj) { const f32x4 v0 = acc[ai][bj][m][0], v1 = acc[ai][bj][m][1];
                    const u32x4 g = *(const u32x4*)(gp + bj * HALF);
                    float r[8];
                    r[0] = sigmoidf_(bflo(g.x)) * v0[0]; r[1] = sigmoidf_(bfhi(g.x)) * v0[1]; r[2] = sigmoidf_(bflo(g.y)) * v0[2]; r[3] = sigmoidf_(bfhi(g.y)) * v0[3];
                    r[4] = sigmoidf_(bflo(g.z)) * v1[0]; r[5] = sigmoidf_(bfhi(g.z)) * v1[1]; r[6] = sigmoidf_(bflo(g.w)) * v1[2]; r[7] = sigmoidf_(bfhi(g.w)) * v1[3];
                    if (ACCUM) { const u32x4 o = *(const u32x4*)(rowp + bj * HALF);
                        r[0] += bflo(o.x); r[1] += bfhi(o.x); r[2] += bflo(o.y); r[3] += bfhi(o.y); r[4] += bflo(o.z); r[5] += bfhi(o.z); r[6] += bflo(o.w); r[7] += bfhi(o.w); }
                    u32x4 w; w.x = cvt_pk_bf16(r[0], r[1]); w.y = cvt_pk_bf16(r[2], r[3]); w.z = cvt_pk_bf16(r[4], r[5]); w.w = cvt_pk_bf16(r[6], r[7]);
                    *(u32x4*)(rowp + bj * HALF) = w; }
                asm volatile("" ::: "memory"); }
    }
};
struct EpiSwiGLU {
    static constexpr bool PERM = true, AFTER_DRAIN = false;
    bf16_t* O; int ldc;
    __device__ __forceinline__ void operator()(const f32x4 (&acc)[2][2][4][2], const Unit& u, int wr, int wc, int fr, int fq) const {
        const int row0 = u.pm * BM + wr * 64 + fr, col0 = u.pn * HALF + wc * 32 + 8 * fq;
#pragma unroll
        for (int ai = 0; ai < 2; ++ai)
#pragma unroll
            for (int m = 0; m < 4; ++m) { bf16_t* rowp = O + (size_t)(row0 + ai * HALF + m * 16) * ldc + col0;
                float r[8];
#pragma unroll
                for (int n = 0; n < 2; ++n)
#pragma unroll
                    for (int j = 0; j < 4; ++j) { const float g = acc[ai][0][m][n][j], up = acc[ai][1][m][n][j]; r[4 * n + j] = g * sigmoidf_(g) * up; }
                u32x4 w; w.x = cvt_pk_bf16(r[0], r[1]); w.y = cvt_pk_bf16(r[2], r[3]); w.z = cvt_pk_bf16(r[4], r[5]); w.w = cvt_pk_bf16(r[6], r[7]);
                *(u32x4*)rowp = w; }
    }
};
struct EpiSwiGLU8 {
    static constexpr bool PERM = true, AFTER_DRAIN = false;
    unsigned char* O; int ldc;
    __device__ __forceinline__ void operator()(const f32x4 (&acc)[2][2][4][2], const Unit& u, int wr, int wc, int fr, int fq) const {
        const int row0 = u.pm * BM + wr * 64 + fr, col0 = u.pn * HALF + wc * 32 + 8 * fq;
#pragma unroll
        for (int ai = 0; ai < 2; ++ai)
#pragma unroll
            for (int m = 0; m < 4; ++m) { unsigned char* rowp = O + (size_t)(row0 + ai * HALF + m * 16) * ldc + col0;
                float r[8];
#pragma unroll
                for (int n = 0; n < 2; ++n)
#pragma unroll
                    for (int j = 0; j < 4; ++j) { const float g = acc[ai][0][m][n][j], up = acc[ai][1][m][n][j]; r[4 * n + j] = g * sigmoidf_(g) * up; }
                typedef unsigned u32x2_ __attribute__((ext_vector_type(2)));
                u32x2_ w; w.x = pk4_fp8(r[0], r[1], r[2], r[3]); w.y = pk4_fp8(r[4], r[5], r[6], r[7]);
                *(u32x2_*)rowp = w; }
    }
};
struct EpiAccF32 {
    static constexpr bool PERM = false, AFTER_DRAIN = false;
    float* O; int ldc; const float* gate; int gstride; int first;
    __device__ __forceinline__ void operator()(const f32x4 (&acc)[2][2][4][2], const Unit& u, int wr, int wc, int fr, int fq) const {
        const int row0 = u.pm * BM + wr * 64 + fr, col0 = u.pn * BM + wc * 32 + 4 * fq;
#pragma unroll
        for (int ai = 0; ai < 2; ++ai)
#pragma unroll
            for (int m = 0; m < 4; ++m) { const int row = row0 + ai * HALF + m * 16; float* rowp = O + (size_t)row * ldc + col0; const float gt = gate ? gate[(size_t)row * gstride] : 1.0f;
#pragma unroll
                for (int bj = 0; bj < 2; ++bj)
#pragma unroll
                    for (int n = 0; n < 2; ++n) { f32x4 v = acc[ai][bj][m][n] * gt; float* p = rowp + bj * HALF + n * 16; if (!first) v += *(const f32x4*)p; *(f32x4*)p = v; }
                asm volatile("" ::: "memory"); }
    }
};

struct MoeOrder {
    int nM, nN, nwg, G, c; int tstart[9]; long bstride;
    int nMn, KS, slice, nwn;
    __device__ __forceinline__ void init(const int (&cnt)[8], int nN_, long bstride_, int G_, int c_, int nMn_ = -1, int KS_ = 1, int slice_ = 0) {
        tstart[0] = 0;
#pragma unroll
        for (int x = 0; x < 8; ++x) tstart[x + 1] = tstart[x] + ((cnt[x] + 255) >> 8);
        nM = tstart[8]; nN = nN_; G = G_; c = c_; bstride = bstride_;
        nMn = nMn_ < 0 ? nM : nMn_; KS = KS_; slice = slice_; nwn = nMn * nN; nwg = nwn + (nM - nMn) * nN * KS;
    }
    __device__ __forceinline__ bool next(int i, Unit& u) const {
        const long L = (long)i * G + c; if (L >= nwg) return false;
        if (L < nwn) {
            int wgid = (int)L; { const int q = nwn / NXCD, r = nwn % NXCD, xcd = wgid % NXCD, off = wgid / NXCD; wgid = (xcd < r ? xcd * (q + 1) : r * (q + 1) + (xcd - r) * q) + off; }
            const int nig = WGM * nN, gid = wgid / nig, fm = gid * WGM, gsz = (nMn - fm) < WGM ? (nMn - fm) : WGM;
            u.pm = fm + ((wgid % nig) % gsz); u.pn = (wgid % nig) / gsz; u.koff = 0; u.nt = 0;
        } else { const int j = (int)L - nwn; u.pm = nMn + j / (nN * KS); u.pn = (j / KS) % nN; u.koff = (long)(j % KS) * slice * 2; u.nt = slice >> 6; }
        int x = 0;
#pragma unroll
        for (int k = 1; k < 8; ++k) x += (u.pm >= tstart[k]) ? 1 : 0;
        u.boff = (long)x * bstride; return true;
    }
    __device__ __forceinline__ void a_ready(const Unit&) const {}
    __device__ __forceinline__ void done(const Unit&) const {}
};

struct CtxSplitOrder {
    StaticOrder lat; int KS, nctx, G, c, slice;
    __device__ __forceinline__ void init(int Mlat, int K, int slice_, int G_, int c_) { lat.init(Mlat, 1024, G_, c_); slice = slice_; KS = K / slice_; nctx = 16 * KS; G = G_; c = c_; }
    __device__ __forceinline__ bool next(int i, Unit& u) const {
        if (lat.next(i, u)) return true;
        const int j = i * G + c - lat.nwg;
        if (j >= nctx) return false;
        u.pm = 64 + j / (4 * KS); u.pn = (j / KS) & 3; u.boff = 0; u.koff = (long)(j % KS) * slice * 2; u.nt = slice >> 6; return true;
    }
    __device__ __forceinline__ void a_ready(const Unit&) const {}
    __device__ __forceinline__ void done(const Unit&) const {}
};
struct BranchOrder {
    StaticOrder lat; int G, c, first, nsub, KH, kslice;
    __device__ __forceinline__ void init(int Mlat, int G_, int c_, int first_, int nsub_, int KH_, int kslice_) { lat.init(Mlat, 1024, G_, c_); G = G_; c = c_; first = first_; nsub = nsub_; KH = KH_; kslice = kslice_; }
    __device__ __forceinline__ bool next(int i, Unit& u) const {
        if (lat.next(i, u)) return true;
        const int j = i * G + c - lat.nwg - first;
        if (j < 0 || j >= nsub) return false;
        const int tile = j / KH, hf = j % KH;
        u.pm = 64 + (tile >> 2); u.pn = tile & 3; u.boff = 0; u.koff = (long)hf * kslice * 2; u.nt = KH > 1 ? (kslice >> 6) : 0; return true;
    }
    __device__ __forceinline__ void a_ready(const Unit&) const {}
    __device__ __forceinline__ void done(const Unit&) const {}
};
template <bool ACCUM, bool ALWAYS_ALT> struct EpiGateBr {
    static constexpr bool PERM = true, AFTER_DRAIN = false;
    bf16_t* O; int ldc; const bf16_t* G; int ldg; bf16_t* ALT;
    __device__ __forceinline__ void operator()(const f32x4 (&acc)[2][2][4][2], const Unit& u, int wr, int wc, int fr, int fq) const {
        const int row0 = u.pm * BM + wr * 64 + fr, col0 = u.pn * BM + wc * 32 + 8 * fq;
        const bool ctx = u.pm >= 64, alt = ctx && (ALWAYS_ALT || u.koff != 0), accum = ACCUM && !ctx;
        bf16_t* ob = alt ? ALT - (size_t)64 * BM * ldc : O;
#pragma unroll
        for (int ai = 0; ai < 2; ++ai) {
            u32x4 gq[4][2], oq[4][2];
#pragma unroll
            for (int m = 0; m < 4; ++m) { const int row = row0 + ai * HALF + m * 16; const bf16_t* gp = G + (size_t)row * ldg + col0; const bf16_t* rowp = ob + (size_t)row * ldc + col0;
#pragma unroll
                for (int bj = 0; bj < 2; ++bj) { gq[m][bj] = *(const u32x4*)(gp + bj * HALF); if (accum) oq[m][bj] = *(const u32x4*)(rowp + bj * HALF); } }
#pragma unroll
            for (int m = 0; m < 4; ++m) { const int row = row0 + ai * HALF + m * 16; bf16_t* rowp = ob + (size_t)row * ldc + col0;
#pragma unroll
                for (int bj = 0; bj < 2; ++bj) { const f32x4 v0 = acc[ai][bj][m][0], v1 = acc[ai][bj][m][1];
                    const u32x4 g = gq[m][bj];
                    float r[8];
                    r[0] = sigmoidf_(bflo(g.x)) * v0[0]; r[1] = sigmoidf_(bfhi(g.x)) * v0[1]; r[2] = sigmoidf_(bflo(g.y)) * v0[2]; r[3] = sigmoidf_(bfhi(g.y)) * v0[3];
                    r[4] = sigmoidf_(bflo(g.z)) * v1[0]; r[5] = sigmoidf_(bfhi(g.z)) * v1[1]; r[6] = sigmoidf_(bflo(g.w)) * v1[2]; r[7] = sigmoidf_(bfhi(g.w)) * v1[3];
                    if (accum) { const u32x4 o = oq[m][bj];
                        r[0] += bflo(o.x); r[1] += bfhi(o.x); r[2] += bflo(o.y); r[3] += bfhi(o.y); r[4] += bflo(o.z); r[5] += bfhi(o.z); r[6] += bflo(o.w); r[7] += bfhi(o.w); }
                    u32x4 w; w.x = cvt_pk_bf16(r[0], r[1]); w.y = cvt_pk_bf16(r[2], r[3]); w.z = cvt_pk_bf16(r[4], r[5]); w.w = cvt_pk_bf16(r[6], r[7]);
                    *(u32x4*)(rowp + bj * HALF) = w; } }
            asm volatile("" ::: "memory"); }
    }
};
struct CtxSplit3Order {
    StaticOrder lat; int G, c, nsub; long a1, a2;
    __device__ __forceinline__ void init(int Mlat, int G_, int c_, long a1_, long a2_, int nsub_) { lat.init(Mlat, 1024, G_, c_); G = G_; c = c_; a1 = a1_; a2 = a2_; nsub = nsub_; }
    __device__ __forceinline__ bool next(int i, Unit& u) const {
        if (lat.next(i, u)) return true;
        const int j = i * G + c - lat.nwg;
        if (j >= nsub) return false;
        const int tile = j / 12, r = j % 12, s = r >> 2, ks = r & 3;
        const long aA = s == 0 ? 0L : (s == 1 ? a1 : a2);
        u.pm = 64 + (tile >> 2); u.pn = tile & 3; u.koff = (long)ks * 512 + aA; u.boff = -aA; u.nt = (r << 8) | 4; return true;
    }
    __device__ __forceinline__ void a_ready(const Unit&) const {}
    __device__ __forceinline__ void done(const Unit&) const {}
};
struct EpiStoreSplit3 {
    static constexpr bool PERM = true, AFTER_DRAIN = false;
    bf16_t* O; int ldc; bf16_t* Pslab;
    __device__ __forceinline__ void operator()(const f32x4 (&acc)[2][2][4][2], const Unit& u, int wr, int wc, int fr, int fq) const {
        const int col0 = u.pn * BM + wc * 32 + 8 * fq;
        bf16_t* base; int row0;
        if (u.pm < 64) { base = O; row0 = u.pm * BM + wr * 64 + fr; }
        else { base = Pslab + (size_t)(u.nt >> 8) * 1024 * ldc; row0 = (u.pm - 64) * BM + wr * 64 + fr; }
#pragma unroll
        for (int ai = 0; ai < 2; ++ai)
#pragma unroll
            for (int m = 0; m < 4; ++m) { bf16_t* rowp = base + (size_t)(row0 + ai * HALF + m * 16) * ldc + col0;
#pragma unroll
                for (int bj = 0; bj < 2; ++bj) { const f32x4 v0 = acc[ai][bj][m][0], v1 = acc[ai][bj][m][1];
                    u32x4 w; w.x = cvt_pk_bf16(v0[0], v0[1]); w.y = cvt_pk_bf16(v0[2], v0[3]); w.z = cvt_pk_bf16(v1[0], v1[1]); w.w = cvt_pk_bf16(v1[2], v1[3]);
                    *(u32x4*)(rowp + bj * HALF) = w; } }
    }
};
struct EpiStoreSplit {
    static constexpr bool PERM = true, AFTER_DRAIN = false;
    bf16_t* O; int ldc; bf16_t* Pslab; int slice2;
    __device__ __forceinline__ void operator()(const f32x4 (&acc)[2][2][4][2], const Unit& u, int wr, int wc, int fr, int fq) const {
        const int col0 = u.pn * BM + wc * 32 + 8 * fq;
        bf16_t* base; int row0;
        if (u.pm < 64) { base = O; row0 = u.pm * BM + wr * 64 + fr; }
        else { base = Pslab + (size_t)(int)(u.koff / slice2) * 1024 * ldc; row0 = (u.pm - 64) * BM + wr * 64 + fr; }
#pragma unroll
        for (int ai = 0; ai < 2; ++ai)
#pragma unroll
            for (int m = 0; m < 4; ++m) { bf16_t* rowp = base + (size_t)(row0 + ai * HALF + m * 16) * ldc + col0;
#pragma unroll
                for (int bj = 0; bj < 2; ++bj) { const f32x4 v0 = acc[ai][bj][m][0], v1 = acc[ai][bj][m][1];
                    u32x4 w; w.x = cvt_pk_bf16(v0[0], v0[1]); w.y = cvt_pk_bf16(v0[2], v0[3]); w.z = cvt_pk_bf16(v1[0], v1[1]); w.w = cvt_pk_bf16(v1[2], v1[3]);
                    *(u32x4*)(rowp + bj * HALF) = w; } }
    }
};

struct EpiMoeDown {
    static constexpr bool PERM = true, AFTER_DRAIN = false;
    bf16_t* O; int ldc; bf16_t* SL; int slice2, split_tile; size_t slab_stride;
    __device__ __forceinline__ void operator()(const f32x4 (&acc)[2][2][4][2], const Unit& u, int wr, int wc, int fr, int fq) const {
        const int col0 = u.pn * BM + wc * 32 + 8 * fq;
        bf16_t* base; int row0;
        if (u.nt == 0) { base = O; row0 = u.pm * BM + wr * 64 + fr; }
        else { base = SL + (size_t)(int)(u.koff / slice2) * slab_stride; row0 = (u.pm - split_tile) * BM + wr * 64 + fr; }
#pragma unroll
        for (int ai = 0; ai < 2; ++ai)
#pragma unroll
            for (int m = 0; m < 4; ++m) { bf16_t* rowp = base + (size_t)(row0 + ai * HALF + m * 16) * ldc + col0;
#pragma unroll
                for (int bj = 0; bj < 2; ++bj) { const f32x4 v0 = acc[ai][bj][m][0], v1 = acc[ai][bj][m][1];
                    u32x4 w; w.x = cvt_pk_bf16(v0[0], v0[1]); w.y = cvt_pk_bf16(v0[2], v0[3]); w.z = cvt_pk_bf16(v1[0], v1[1]); w.w = cvt_pk_bf16(v1[2], v1[3]);
                    *(u32x4*)(rowp + bj * HALF) = w; } }
    }
};

struct EpiProj {
    static constexpr bool PERM = true, AFTER_DRAIN = false;
    bf16_t* O; int ldc; bf16_t* NVT; int nv0; int nblk;
    __device__ __forceinline__ void operator()(const f32x4 (&acc)[2][2][4][2], const Unit& u, int wr, int wc, int fr, int fq) const {
        const int row0 = u.pm * BM + wr * 64 + fr;
        if (u.pn != nv0 && u.pn != nv0 + 1) {
            const int col0 = u.pn * BM + wc * 32 + 8 * fq;
#pragma unroll
            for (int ai = 0; ai < 2; ++ai)
#pragma unroll
                for (int m = 0; m < 4; ++m) { bf16_t* rowp = O + (size_t)(row0 + ai * HALF + m * 16) * ldc + col0;
#pragma unroll
                    for (int bj = 0; bj < 2; ++bj) { const f32x4 v0 = acc[ai][bj][m][0], v1 = acc[ai][bj][m][1];
                        u32x4 w; w.x = cvt_pk_bf16(v0[0], v0[1]); w.y = cvt_pk_bf16(v0[2], v0[3]); w.z = cvt_pk_bf16(v1[0], v1[1]); w.w = cvt_pk_bf16(v1[2], v1[3]);
                        *(u32x4*)(rowp + bj * HALF) = w; } }
        } else {
#pragma unroll
            for (int ai = 0; ai < 2; ++ai)
#pragma unroll
                for (int m = 0; m < 4; ++m) { const int row = row0 + ai * HALF + m * 16;
#pragma unroll
                    for (int bj = 0; bj < 2; ++bj) { const int cl = bj * HALF + wc * 32 + 8 * fq; const int h = 4 * (u.pn - nv0) + (cl >> 6), d0 = cl & 63;
                        bf16_t* p = NVT + (((size_t)h * nblk + (row >> 3)) * 64 + d0) * 8 + (row & 7);
                        const f32x4 v0 = acc[ai][bj][m][0], v1 = acc[ai][bj][m][1];
                        const unsigned w0 = cvt_pk_bf16(v0[0], v0[1]), w1 = cvt_pk_bf16(v0[2], v0[3]), w2 = cvt_pk_bf16(v1[0], v1[1]), w3 = cvt_pk_bf16(v1[2], v1[3]);
                        p[0] = (bf16_t)(w0 & 0xffffu); p[8] = (bf16_t)(w0 >> 16); p[16] = (bf16_t)(w1 & 0xffffu); p[24] = (bf16_t)(w1 >> 16);
                        p[32] = (bf16_t)(w2 & 0xffffu); p[40] = (bf16_t)(w2 >> 16); p[48] = (bf16_t)(w3 & 0xffffu); p[56] = (bf16_t)(w3 >> 16); }
                    asm volatile("" ::: "memory"); }
        }
    }
};
template <class Epi, class Sched, bool ALIGN_EPI = false, bool SP2 = false, bool F8 = false>
__device__ __forceinline__ void gemm_phase(PG8_LAS unsigned char* lds, const Gemm g, const Sched& S, const Epi& E, int scaleW = 127, int scaleA = 127) {
    int tid_ = threadIdx.x; asm volatile("" : "+v"(tid_)); const int tid = tid_, wid = __builtin_amdgcn_readfirstlane(tid >> 6), lane = tid & 63, wr = wid >> 2, wc = wid & 3, fr = lane & 15, fq = lane >> 4;
    int scW_ = scaleW, scA_ = scaleA; (void)scW_; (void)scA_;
    const int K = g.K, ntf = K / BK;
    unsigned voffA[2], voffB[2];
#pragma unroll
    for (int i = 0; i < 2; ++i) { int R, C; stage_rc(tid * 16 + i * 8192, R, C); const int Rb = Epi::PERM ? ((R & ~31) + perm32(R & 31)) : R;
        voffA[i] = (unsigned)(R * K + C) * 2u; voffB[i] = (unsigned)(Rb * K + C) * 2u; }
    const size_t kstep = (size_t)(BK * 2);
    const size_t hstep = (size_t)HALF * K * 2;
    const size_t tstep = 2 * hstep;
    const unsigned ldsw = (unsigned)wid * 1024u;
    const int aoff = lds_byte(wr * 64 + fr, fq * 8), boff = lds_byte(wc * 32 + fr, fq * 8);
#define PG8_SA(b, h) (((b) * 2 + (h)) * HTB)
#define PG8_SB(b, h) ((4 + (b) * 2 + (h)) * HTB)
#define PG8_STAGE(bufoff, gbase, voff) do { _Pragma("unroll") for (int _i = 0; _i < 2; ++_i) \
        __builtin_amdgcn_global_load_lds((const unsigned*)((const char*)(gbase) + (voff)[_i]), (PG8_LAS unsigned*)(lds + (bufoff) + ldsw + _i * 8192), 16, 0, 0); } while (0)
#define PG8_LDA(dst, b, h) do { _Pragma("unroll") for (int m = 0; m < 4; ++m) _Pragma("unroll") for (int k = 0; k < 2; ++k) dst[m][k] = *(const PG8_LAS bf16x8*)(lds + PG8_SA(b, h) + aoff + m * 2048 + k * 1024); } while (0)
#define PG8_LDB(dst, b, h) do { _Pragma("unroll") for (int n = 0; n < 2; ++n) _Pragma("unroll") for (int k = 0; k < 2; ++k) dst[n][k] = *(const PG8_LAS bf16x8*)(lds + PG8_SB(b, h) + boff + n * 2048 + k * 1024); } while (0)
#define PG8_MMA(ai, bj, At, Bt) do { __builtin_amdgcn_s_setprio(1); _Pragma("unroll") for (int m = 0; m < 4; ++m) _Pragma("unroll") for (int n = 0; n < 2; ++n) { \
        if constexpr (F8) { struct P2_ { bf16x8 lo, hi; }; const P2_ pb_{Bt[n][0], Bt[n][1]}, pa_{At[m][0], At[m][1]}; \
            const v8i_t b8_ = __builtin_bit_cast(v8i_t, pb_), a8_ = __builtin_bit_cast(v8i_t, pa_); \
            asm volatile("v_mfma_scale_f32_16x16x128_f8f6f4 %0, %1, %2, %0, %3, %4 op_sel_hi:[0,0,0]" : "+v"(acc[ai][bj][m][n]) : "v"(b8_), "v"(a8_), "v"(scW_), "v"(scA_)); } \
        else { _Pragma("unroll") for (int k = 0; k < 2; ++k) acc[ai][bj][m][n] = __builtin_amdgcn_mfma_f32_16x16x32_bf16(Bt[n][k], At[m][k], acc[ai][bj][m][n], 0, 0, 0); } } \
        __builtin_amdgcn_s_setprio(0); } while (0)
#define PG8_WAIT_V(n) asm volatile("s_waitcnt vmcnt(" #n ")" ::: "memory")
#define PG8_WAIT_L(n) asm volatile("s_waitcnt lgkmcnt(" #n ")" ::: "memory")
#define PG8_BAR __builtin_amdgcn_s_barrier()
#define PG8_SCHED __builtin_amdgcn_sched_barrier(0)
    Unit cur, nxt; int ui = 0;
    if (!S.next(0, cur)) return;
    f32x4 acc[2][2][4][2];
#pragma unroll
    for (int a = 0; a < 2; ++a)
#pragma unroll
        for (int b = 0; b < 2; ++b)
#pragma unroll
            for (int m = 0; m < 4; ++m)
#pragma unroll
                for (int n = 0; n < 2; ++n) acc[a][b][m][n] = (f32x4){0.f, 0.f, 0.f, 0.f};
    bf16x8 At[4][2], B0[2][2], B1[2][2];
    const char* cA = (const char*)g.A + cur.koff + (size_t)cur.pm * tstep; const char* cB = (const char*)g.Bt + cur.boff + cur.koff + (size_t)cur.pn * tstep;
    S.a_ready(cur);
    if constexpr (SP2) {
        PG8_STAGE(PG8_SB(0, 0), cB, voffB); PG8_STAGE(PG8_SB(0, 1), cB + hstep, voffB); PG8_STAGE(PG8_SA(0, 0), cA, voffA); PG8_STAGE(PG8_SA(0, 1), cA + hstep, voffA);
        if (wr == 1) PG8_BAR;
        PG8_WAIT_V(2); PG8_BAR;
        PG8_STAGE(PG8_SB(1, 0), cB + kstep, voffB); PG8_STAGE(PG8_SA(1, 0), cA + kstep, voffA); PG8_STAGE(PG8_SB(1, 1), cB + hstep + kstep, voffB);
        PG8_WAIT_V(6); PG8_BAR;
    } else {
        PG8_STAGE(PG8_SB(0, 0), cB, voffB); PG8_STAGE(PG8_SA(0, 0), cA, voffA); PG8_STAGE(PG8_SB(0, 1), cB + hstep, voffB); PG8_STAGE(PG8_SA(0, 1), cA + hstep, voffA);
        if (wr == 1) PG8_BAR;
        PG8_WAIT_V(4); PG8_BAR;
        PG8_STAGE(PG8_SB(1, 0), cB + kstep, voffB); PG8_STAGE(PG8_SA(1, 0), cA + kstep, voffA); PG8_STAGE(PG8_SB(1, 1), cB + hstep + kstep, voffB);
        PG8_WAIT_V(6); PG8_BAR;
    }
    for (;;) {
        const bool has_next = S.next(ui + 1, nxt);
        const char* nA = has_next ? (const char*)g.A + nxt.koff + (size_t)nxt.pm * tstep : cA; const char* nB = has_next ? (const char*)g.Bt + nxt.boff + nxt.koff + (size_t)nxt.pn * tstep : cB;
        int nt = (cur.nt & 255) ? (cur.nt & 255) : ntf; asm volatile("" : "+s"(nt));
        for (int t = 0; t < nt; t += 2) {
            const bool last = (t == nt - 2);
            const char* a1 = cA + (size_t)(t + 1) * kstep;
            const char* a2 = last ? nA : cA + (size_t)(t + 2) * kstep; const char* b2 = last ? nB : cB + (size_t)(t + 2) * kstep;
            const char* a3 = a2 + kstep; const char* b3 = b2 + kstep;
            if (last && has_next) S.a_ready(nxt);
            if constexpr (SP2) {
            PG8_LDB(B0, 0, 0); PG8_LDB(B1, 0, 1); PG8_SCHED; PG8_LDA(At, 0, 0); PG8_STAGE(PG8_SA(1, 1), a1 + hstep, voffA);
            PG8_WAIT_V(8); PG8_WAIT_L(0); PG8_BAR; PG8_MMA(0, 0, At, B0); PG8_MMA(0, 1, At, B1); PG8_BAR; PG8_SCHED;
            PG8_LDA(At, 0, 1); PG8_STAGE(PG8_SB(0, 0), b2, voffB); PG8_STAGE(PG8_SB(0, 1), b2 + hstep, voffB); PG8_STAGE(PG8_SA(0, 0), a2, voffA);
            PG8_WAIT_V(8); PG8_WAIT_L(0); PG8_BAR; PG8_MMA(1, 0, At, B0); PG8_MMA(1, 1, At, B1); PG8_BAR; PG8_SCHED;
            PG8_LDB(B0, 1, 0); PG8_LDB(B1, 1, 1); PG8_SCHED; PG8_LDA(At, 1, 0); PG8_STAGE(PG8_SA(0, 1), a2 + hstep, voffA);
            PG8_WAIT_V(8); PG8_WAIT_L(0); PG8_BAR; PG8_MMA(0, 0, At, B0); PG8_MMA(0, 1, At, B1); PG8_BAR; PG8_SCHED;
            PG8_LDA(At, 1, 1); PG8_STAGE(PG8_SB(1, 0), b3, voffB); PG8_STAGE(PG8_SB(1, 1), b3 + hstep, voffB); PG8_STAGE(PG8_SA(1, 0), a3, voffA);
            PG8_WAIT_V(8); PG8_WAIT_L(0); PG8_BAR; PG8_MMA(1, 0, At, B0); PG8_MMA(1, 1, At, B1); PG8_BAR; PG8_SCHED;
            } else {
            PG8_LDB(B0, 0, 0); PG8_SCHED; PG8_LDA(At, 0, 0); PG8_STAGE(PG8_SA(1, 1), a1 + hstep, voffA);
            PG8_WAIT_L(8); PG8_BAR; PG8_WAIT_L(0); PG8_MMA(0, 0, At, B0); PG8_BAR; PG8_SCHED;
            PG8_LDB(B1, 0, 1); PG8_STAGE(PG8_SB(0, 0), b2, voffB);
            PG8_BAR; PG8_WAIT_L(0); PG8_MMA(0, 1, At, B1); PG8_BAR;
            PG8_LDA(At, 0, 1); PG8_STAGE(PG8_SA(0, 0), a2, voffA);
            PG8_BAR; PG8_WAIT_L(0); PG8_MMA(1, 0, At, B0); PG8_BAR; PG8_SCHED;
            PG8_STAGE(PG8_SB(0, 1), b2 + hstep, voffB);
            PG8_WAIT_V(6); PG8_BAR; PG8_MMA(1, 1, At, B1); PG8_BAR;
            PG8_LDB(B0, 1, 0); PG8_SCHED; PG8_LDA(At, 1, 0); PG8_STAGE(PG8_SA(0, 1), a2 + hstep, voffA);
            PG8_WAIT_L(8); PG8_BAR; PG8_WAIT_L(0); PG8_MMA(0, 0, At, B0); PG8_BAR; PG8_SCHED;
            PG8_LDB(B1, 1, 1); PG8_STAGE(PG8_SB(1, 0), b3, voffB);
            PG8_BAR; PG8_WAIT_L(0); PG8_MMA(0, 1, At, B1); PG8_BAR;
            PG8_LDA(At, 1, 1); PG8_STAGE(PG8_SA(1, 0), a3, voffA);
            PG8_BAR; PG8_WAIT_L(0); PG8_MMA(1, 0, At, B0); PG8_BAR; PG8_SCHED;
            PG8_STAGE(PG8_SB(1, 1), b3 + hstep, voffB);
            PG8_WAIT_V(6); PG8_BAR; PG8_MMA(1, 1, At, B1); PG8_BAR;
            }
        }
        if constexpr (F8) asm volatile("s_nop 15\n\ts_nop 15\n\ts_nop 15\n\ts_nop 15\n\ts_nop 15\n\ts_nop 15" ::: "memory");
        if constexpr (ALIGN_EPI) { if (wr == 0) PG8_BAR; }
        if constexpr (!Epi::AFTER_DRAIN) { E(acc, cur, wr, wc, fr, fq); S.done(cur); }
        if (!has_next) break;
#pragma unroll
        for (int a = 0; a < 2; ++a)
#pragma unroll
            for (int b = 0; b < 2; ++b)
#pragma unroll
                for (int m = 0; m < 4; ++m)
#pragma unroll
                    for (int n = 0; n < 2; ++n) acc[a][b][m][n] = (f32x4){0.f, 0.f, 0.f, 0.f};
        cur = nxt; cA = nA; cB = nB; ++ui;
        if constexpr (ALIGN_EPI) { if (wr == 1) PG8_BAR; }
    }
    PG8_WAIT_V(0);
    if constexpr (!ALIGN_EPI) { if (wr == 0) PG8_BAR; }
    PG8_BAR;
    if constexpr (Epi::AFTER_DRAIN) { E.fused(acc, cur, wr, wc, fr, fq, lds, wid, lane); S.done(cur); }
#undef PG8_SA
#undef PG8_SB
#undef PG8_STAGE
#undef PG8_LDA
#undef PG8_LDB
#undef PG8_MMA
#undef PG8_WAIT_V
#undef PG8_WAIT_L
#undef PG8_BAR
#undef PG8_SCHED
}
}

#ifndef PG8_SP2
#define PG8_SP2 true
#endif
#ifndef PG8_ALIGN
#define PG8_ALIGN true
#endif
#ifndef SITE_PROJ
#define SITE_PROJ 1
#endif
#ifndef SITE_BR
#define SITE_BR 1
#endif
#ifndef SITE_OUT
#define SITE_OUT 1
#endif
#ifndef SITE_UP
#define SITE_UP 1
#endif
#ifndef SITE_DOWN
#define SITE_DOWN 1
#endif
#ifndef SITE_THIN
#define SITE_THIN 1
#endif
#ifndef DENSE_FP8
#define DENSE_FP8 1
#endif
#ifndef MK_MULTI
#define MK_MULTI 0
#endif

constexpr int NWAVES = 8;
constexpr int D = 1024, BATCH = 4, SEQ = 4096, DEPTH = 4, CTX = 256;
constexpr int TL = BATCH * SEQ, TC = BATCH * CTX, T = TL + TC;
constexpr int DFF = 3584, NEXP = 8, DIN = 6688;
constexpr int NPROJ = 7680;
constexpr int PC_GQ = 0, PC_GK = 512, PC_GV = 1024, PC_GR = 2048, PC_ZF = 3072, PC_ZB = 3584, PC_NQ = 4096, PC_NK = 4608, PC_NV = 5120, PC_GA = 5632, PC_GB = 6656;
constexpr float EPS = 1e-6f;
enum { I_X = 0, I_C, I_CTX, I_CCTX, I_WMOD, I_BMOD, I_NMPRE, I_NMPOST, I_WIN, I_GW2, I_GB, I_GNORM, I_RPB, I_WBG, I_WBN, I_WOUT, I_NFPRE, I_NFPOST, I_F1, I_F3, I_F2, I_ROUTER, I_M1, I_M3, I_M2, N_IN };

constexpr size_t MiB = 1u << 20;
constexpr size_t WS_CTL = 0, CTL_ZERO_BYTES = 1 * MiB;
constexpr size_t WS_MODS = 1 * MiB;
constexpr size_t WS_ROPE = WS_MODS + 512 * 1024;
constexpr size_t WS_SLOT = 2 * MiB;
constexpr size_t WS_WT = WS_SLOT + 512 * 1024;
constexpr size_t WS_DEST = WS_WT + 256 * 1024;
constexpr size_t WS_CNTW = WS_DEST + 256 * 1024;
constexpr size_t WS_WIN = 4 * MiB;
constexpr size_t WS_WBG = WS_WIN + 4 * 15 * MiB;
constexpr size_t WS_WBN = WS_WBG + 4 * 2 * MiB;
constexpr size_t WS_WO = WS_WBN + 4 * 1 * MiB;
constexpr size_t WS_W13 = WS_WO + 4 * 2 * MiB;
constexpr size_t WS_W2 = WS_W13 + 18 * 14 * MiB;
constexpr size_t WS_X = WS_W2 + 18 * 7 * MiB;
constexpr size_t WS_H = WS_X + 68 * MiB;
constexpr size_t WS_YN = WS_H;
constexpr size_t WS_NK = WS_H + 17 * MiB;
constexpr size_t WS_A = WS_H + 34 * MiB;
constexpr size_t WS_PROJ = WS_A;
constexpr size_t WS_GBLK = WS_PROJ + 255 * MiB;
constexpr size_t WS_VTB = WS_GBLK + 77 * MiB;
constexpr size_t WS_OINTRA = WS_VTB + 39 * MiB;
constexpr size_t WS_OIF = WS_OINTRA + 34 * MiB;
constexpr size_t WS_OIB = WS_OIF + 34 * MiB;
constexpr size_t WS_NVT = WS_OIB + 34 * MiB;
constexpr size_t WS_YC = WS_OIB;
constexpr size_t WS_FC = WS_OIB + 8 * MiB;
constexpr size_t WS_YG = WS_OINTRA;
constexpr size_t WS_MB = WS_GBLK;
constexpr size_t WS_MB2 = WS_MB + 36 * MiB;
constexpr size_t WS_MB3 = WS_MB + 38 * MiB;
constexpr size_t WS_Y = WS_OIF;
constexpr int MOE_MAXROWS = 143 * 256;
constexpr size_t WS_XG = WS_A;
constexpr size_t WS_HID = WS_XG + 72 * MiB;
constexpr size_t WS_FS = WS_HID + 251 * MiB;
constexpr size_t WS_END = WS_NVT + 17 * MiB;
static_assert(WS_END <= 1065 * MiB, "workspace map exceeds the guaranteed size");
static_assert(WS_FS + 72 * MiB <= WS_Y, "ffn overlay ends below Y (read by post_mix only, but keep clear)");
constexpr int GB_QE = 0, GB_KDT = 17408, GB_DEC = 35840, GB_BYTES = 36864, VT_BYTES = 36864;
constexpr int CW_BAR = 4096;
constexpr int CW_MOE = 12288;

constexpr int RING_BYTES = 131072;
constexpr int LDSCTL_OFF = 143360, MISC_OFF = LDSCTL_OFF + 320;
constexpr int LDS_BYTES = 147456;

#define GAS __attribute__((address_space(1)))
#define LAS __attribute__((address_space(3)))
typedef unsigned short bf16;
typedef unsigned v4u __attribute__((ext_vector_type(4)));
typedef unsigned v2u __attribute__((ext_vector_type(2)));
typedef float f32x4 __attribute__((ext_vector_type(4)));
typedef float f32x2 __attribute__((ext_vector_type(2)));
typedef GAS unsigned gu32;
#define RLX_AGENT __ATOMIC_RELAXED, __HIP_MEMORY_SCOPE_AGENT
#define LDS_WAIT() asm volatile("s_waitcnt lgkmcnt(0)" ::: "memory")
#define VM_WAIT() asm volatile("s_waitcnt vmcnt(0)" ::: "memory")
using pg8::bflo; using pg8::bfhi; using pg8::cvt_pk_bf16;
__device__ __forceinline__ float bf2f(bf16 h) { return __uint_as_float((unsigned)h << 16); }
__device__ __forceinline__ float wave_sum(float v) {
    v += __builtin_bit_cast(float, __builtin_amdgcn_update_dpp(0, __builtin_bit_cast(int, v), 0x111, 0xf, 0xf, true));
    v += __builtin_bit_cast(float, __builtin_amdgcn_update_dpp(0, __builtin_bit_cast(int, v), 0x112, 0xf, 0xf, true));
    v += __builtin_bit_cast(float, __builtin_amdgcn_update_dpp(0, __builtin_bit_cast(int, v), 0x114, 0xf, 0xf, true));
    v += __builtin_bit_cast(float, __builtin_amdgcn_update_dpp(0, __builtin_bit_cast(int, v), 0x118, 0xf, 0xf, true));
    v += __builtin_bit_cast(float, __builtin_amdgcn_update_dpp(0, __builtin_bit_cast(int, v), 0x142, 0xa, 0xf, false));
    v += __builtin_bit_cast(float, __builtin_amdgcn_update_dpp(0, __builtin_bit_cast(int, v), 0x143, 0xc, 0xf, false));
    return __int_as_float(__builtin_amdgcn_readlane(__float_as_int(v), 63));
}
__device__ __forceinline__ float wave_max(float v) {
#pragma unroll
    for (int o = 1; o < 64; o <<= 1) v = fmaxf(v, __shfl_xor(v, o));
    return v;
}
__device__ __forceinline__ float sq4(f32x4 v) { return (v.x * v.x + v.y * v.y) + (v.z * v.z + v.w * v.w); }
__device__ __forceinline__ f32x4 unpack4(v2u w) { return (f32x4){bflo(w.x), bfhi(w.x), bflo(w.y), bfhi(w.y)}; }
__device__ __forceinline__ v2u pack4(f32x4 v) { v2u w; w.x = cvt_pk_bf16(v.x, v.y); w.y = cvt_pk_bf16(v.z, v.w); return w; }
__device__ __forceinline__ float siluf_(float x) { return x * pg8::sigmoidf_(x); }

#define XB_TMO      128
#define XB_XCNT(j)  (256  + 64 * (j))
#define XB_XSUB(j)  (1280 + 64 * (j))
#define XB_XGEN(j)  (2304 + 64 * (j))
#define XB_TOP      3328
#define XB_TOPGEN   3392
#define XCD_BAR_WORDS 3456
#define XB_SPIN_CAP (1u << 18)

__device__ __forceinline__ unsigned xb_ld(unsigned* p)              { return __hip_atomic_load(p, __ATOMIC_RELAXED, __HIP_MEMORY_SCOPE_AGENT); }
__device__ __forceinline__ unsigned xb_add(unsigned* p, unsigned v) { return __hip_atomic_fetch_add(p, v, __ATOMIC_RELAXED, __HIP_MEMORY_SCOPE_AGENT); }
__device__ __forceinline__ unsigned xb_xcc_id() { return (unsigned)__builtin_amdgcn_s_getreg((3 << 11) | 20) & 0xFu; }
#define XB_SPIN(cond, bar) do { unsigned _sp = 0; while (cond) { __builtin_amdgcn_s_sleep(1); \
    if ((++_sp & 255u) == 0u) { if (xb_ld(&(bar)[XB_TMO])) break; if (_sp > XB_SPIN_CAP) { atomicAdd(&(bar)[XB_TMO], 1u); break; } } } } while (0)

struct XcdBarrier {
    unsigned* bar; unsigned x;
    volatile LAS unsigned* st;
};

__device__ __forceinline__ XcdBarrier xcd_barrier_post(unsigned* bar, volatile LAS unsigned* st) {
    XcdBarrier b; b.bar = bar; b.x = xb_xcc_id(); b.st = st;
    if (threadIdx.x == 0) (void)xb_add(&bar[XB_XCNT(b.x)], 1u);
    return b;
}
__device__ __forceinline__ void xcd_barrier_complete(unsigned* bar, unsigned x, unsigned& nloc, unsigned& nx) {
    const unsigned G = gridDim.x * gridDim.y * gridDim.z;
    unsigned sum, cnt, mine, sp = 0u;
    for (;;) {
        sum = 0u; cnt = 0u; mine = 0u;
        unsigned cj[16];
#pragma unroll
        for (unsigned j = 0; j < 16; ++j) cj[j] = xb_ld(&bar[XB_XCNT(j)]);
        asm volatile("" ::: "memory");
#pragma unroll
        for (unsigned j = 0; j < 16; ++j) { const unsigned c = cj[j]; sum += c; cnt += (c > 0u) ? 1u : 0u; mine = (j == x) ? c : mine; }
        if (sum == G) break;
        __builtin_amdgcn_s_sleep(1);
        if ((++sp & 255u) == 0u) { if (xb_ld(&bar[XB_TMO])) break; if (sp > XB_SPIN_CAP) { atomicAdd(&bar[XB_TMO], 1u); break; } }
    }
    nloc = mine > 0u ? mine : 1u; nx = cnt > 0u ? cnt : 1u;
}

template <bool CENSUS = true> __device__ __forceinline__ void xcd_barrier(const XcdBarrier& b) {
    asm volatile("s_waitcnt vmcnt(0)" ::: "memory");
    __syncthreads();
    if (threadIdx.x == 0) {
        unsigned* bar = b.bar; asm volatile("" : "+s"(bar));
        __builtin_amdgcn_s_waitcnt(0);
        asm volatile("buffer_inv sc1" ::: "memory");
        unsigned nloc = b.st[0], nx = b.st[1];
        if (CENSUS && nloc == 0u) { xcd_barrier_complete(bar, b.x, nloc, nx); b.st[0] = nloc; b.st[1] = nx; }
        const unsigned old = xb_add(&bar[XB_XSUB(b.x)], 1u);
        const unsigned gen = old / nloc;
        if (old + 1u == (gen + 1u) * nloc) {
            __builtin_amdgcn_fence(__ATOMIC_RELEASE, "agent");
            asm volatile("s_waitcnt vmcnt(0)" ::: "memory");
            const unsigned og = xb_add(&bar[XB_TOP], 1u);
            const unsigned tg = og / nx;
            if (og + 1u == (tg + 1u) * nx) xb_add(&bar[XB_TOPGEN], 1u);
            else XB_SPIN(xb_ld(&bar[XB_TOPGEN]) == tg, bar);
            asm volatile("" ::: "memory");
            asm volatile("s_waitcnt vmcnt(0)" ::: "memory");
        } else {
            XB_SPIN(xb_ld(&bar[XB_TOPGEN]) == gen, bar);
            asm volatile("" ::: "memory");
            asm volatile("s_waitcnt vmcnt(0)" ::: "memory");
        }
    }
    __syncthreads();
}


__device__ __forceinline__ int otid() { int t = threadIdx.x; asm volatile("" : "+v"(t)); return t; }
typedef const float* const __attribute__((address_space(4)))* KIN;
struct Frame {
    LAS unsigned char* lds;
    int tid, lane, wave, G, bx;
    KIN in;
    unsigned char* ws;
    float* out;
};
#define WSP(T_, off) ((T_*)(F.ws + (off)))

__device__ __forceinline__ void p0_transpose_item(const float* W, int K, int N, int kb, int nb, bf16* WT, int drow0, LAS float* scr, int lane) {
    const int k0 = 64 * kb, n0 = 32 * nb;
    f32x4 t[8];
#pragma unroll
    for (int i = 0; i < 8; ++i) t[i] = *(const f32x4*)(W + (size_t)(k0 + 8 * i + (lane >> 3)) * N + n0 + 4 * (lane & 7));
#pragma unroll
    for (int i = 0; i < 8; ++i) *(LAS f32x4*)(scr + (8 * i + (lane >> 3)) * 36 + 4 * (lane & 7)) = t[i];
    LDS_WAIT(); asm volatile("" ::: "memory");
    const int c = lane & 7;
#pragma unroll
    for (int j = 0; j < 4; ++j) { const int n = (lane >> 3) + 8 * j; const LAS float* s = scr + (8 * c) * 36 + n;
        v4u o; o.x = cvt_pk_bf16(s[0 * 36], s[1 * 36]); o.y = cvt_pk_bf16(s[2 * 36], s[3 * 36]); o.z = cvt_pk_bf16(s[4 * 36], s[5 * 36]); o.w = cvt_pk_bf16(s[6 * 36], s[7 * 36]);
        *(GAS v4u*)(WT + (size_t)(drow0 + n) * K + k0 + 8 * c) = o; }
    LDS_WAIT(); asm volatile("" ::: "memory");
}
__device__ __forceinline__ void p0_transpose_item_f8(const float* W, int K, int N, int kb, int nb, unsigned char* WT, int drow0, LAS float* scr, int lane) {
    const int k0 = 64 * kb, n0 = 32 * nb;
    f32x4 t[8];
#pragma unroll
    for (int i = 0; i < 8; ++i) t[i] = *(const f32x4*)(W + (size_t)(k0 + 8 * i + (lane >> 3)) * N + n0 + 4 * (lane & 7));
#pragma unroll
    for (int i = 0; i < 8; ++i) *(LAS f32x4*)(scr + (8 * i + (lane >> 3)) * 36 + 4 * (lane & 7)) = t[i] * 32.0f;
    LDS_WAIT(); asm volatile("" ::: "memory");
    const int c = lane & 3;
#pragma unroll
    for (int j = 0; j < 2; ++j) { const int n = (lane >> 2) + 16 * j; const LAS float* s = scr + (16 * c) * 36 + n;
        v4u o; o.x = pg8::pk4_fp8(s[0 * 36], s[1 * 36], s[2 * 36], s[3 * 36]); o.y = pg8::pk4_fp8(s[4 * 36], s[5 * 36], s[6 * 36], s[7 * 36]);
        o.z = pg8::pk4_fp8(s[8 * 36], s[9 * 36], s[10 * 36], s[11 * 36]); o.w = pg8::pk4_fp8(s[12 * 36], s[13 * 36], s[14 * 36], s[15 * 36]);
        *(GAS v4u*)(WT + (size_t)(drow0 + n) * K + k0 + 16 * c) = o; }
    LDS_WAIT(); asm volatile("" ::: "memory");
}
struct G0Item { const float* W; unsigned char* WT; int K, N, k0, n0, drow0, f8; };
__device__ __forceinline__ bool g0_decode(Frame& F, int it, G0Item& d) {
    static_assert(DENSE_FP8 == 1, "the FFN items below are 128-k fp8 blocks");
    constexpr int IT_WIN = 16 * 209, IT_BG = 16 * 32, IT_BN = 8 * 32, IT_WO = 16 * 32, IT_LAYER = IT_WIN + IT_BG + IT_BN + IT_WO, IT_FF = 8 * 112, IT_SET = 3 * IT_FF;
    if (it < 4 * IT_LAYER) {
        const int l = it / IT_LAYER; int r = it % IT_LAYER; d.f8 = 0;
        if (r < IT_WIN) { const int kb = r / 209, nb = r % 209; if (nb == 96) return false;
            d.W = F.in[I_WIN] + (size_t)l * D * DIN; d.K = D; d.N = DIN; d.k0 = 64 * kb; d.n0 = 32 * nb; d.WT = F.ws + WS_WIN + (size_t)l * NPROJ * D * 2; d.drow0 = nb < 96 ? 32 * nb : 32 * nb + 992; return true; }
        r -= IT_WIN;
        if (r < IT_BG) { d.W = F.in[I_WBG] + (size_t)l * D * D; d.K = D; d.N = D; d.k0 = 64 * (r / 32); d.n0 = 32 * (r % 32); d.WT = F.ws + WS_WBG + (size_t)l * D * D * 2; d.drow0 = d.n0; return true; }
        r -= IT_BG;
        if (r < IT_BN) { d.W = F.in[I_WBN] + (size_t)l * 512 * D; d.K = 512; d.N = D; d.k0 = 64 * (r / 32); d.n0 = 32 * (r % 32); d.WT = F.ws + WS_WBN + (size_t)l * D * 512 * 2; d.drow0 = d.n0; return true; }
        r -= IT_BN;
        d.W = F.in[I_WOUT] + (size_t)l * D * D; d.K = D; d.N = D; d.k0 = 64 * (r / 32); d.n0 = 32 * (r % 32); d.WT = F.ws + WS_WO + (size_t)l * D * D * 2; d.drow0 = d.n0; return true;
    }
    const int it2 = it - 4 * IT_LAYER; const int s = it2 / IT_SET; int r = it2 % IT_SET; const int which = r / IT_FF; r %= IT_FF;
    const size_t so = (size_t)(s < 2 ? s : s - 2) * D * DFF;
    d.f8 = (DENSE_FP8 || s >= 2) ? 1 : 0;
    if (which < 2) {
        d.W = (s < 2 ? (which ? F.in[I_F3] : F.in[I_F1]) : (which ? F.in[I_M3] : F.in[I_M1])) + so; d.K = D; d.N = DFF;
        const int kb = r / 112, nb = r % 112; const int c0 = 32 * nb; d.k0 = 128 * kb; d.n0 = c0; d.drow0 = (c0 >> 7) * 256 + which * 128 + (c0 & 127);
        d.WT = F.ws + WS_W13 + (size_t)s * 7168 * D * 2;
    } else {
        d.W = (s < 2 ? F.in[I_F2] : F.in[I_M2]) + so; d.K = DFF; d.N = D; d.k0 = 128 * (r / 32); d.n0 = 32 * (r % 32); d.drow0 = d.n0;
        d.WT = F.ws + WS_W2 + (size_t)s * D * DFF * 2;
    }
    return true;
}
__device__ __forceinline__ void g0_load(const G0Item& d, int lane, f32x4 (&t)[16]) {
#pragma unroll
    for (int i = 0; i < 8; ++i) t[i] = __builtin_nontemporal_load((const GAS f32x4*)(d.W + (size_t)(d.k0 + 8 * i + (lane >> 3)) * d.N + d.n0 + 4 * (lane & 7)));
    if (d.f8) {
#pragma unroll
        for (int i = 8; i < 16; ++i) t[i] = __builtin_nontemporal_load((const GAS f32x4*)(d.W + (size_t)(d.k0 + 8 * i + (lane >> 3)) * d.N + d.n0 + 4 * (lane & 7))); }
}
__device__ __forceinline__ void g0_finish(const G0Item& d, const f32x4 (&t)[16], LAS float* scr, int lane) {
    if (d.f8) {
#pragma unroll
        for (int i = 0; i < 16; ++i) { LAS f32x2* q = (LAS f32x2*)(scr + (8 * i + (lane >> 3)) * 34 + 4 * (lane & 7)); const f32x4 v = t[i] * 32.0f; q[0] = (f32x2){v.x, v.y}; q[1] = (f32x2){v.z, v.w}; }
    } else {
#pragma unroll
        for (int i = 0; i < 8; ++i) *(LAS f32x4*)(scr + (8 * i + (lane >> 3)) * 36 + 4 * (lane & 7)) = t[i];
    }
    LDS_WAIT(); asm volatile("" ::: "memory");
    if (d.f8) { const int n = lane & 31;
#pragma unroll
        for (int j = 0; j < 4; ++j) { const int c = (lane >> 5) + 2 * j; const LAS float* s = scr + (16 * c) * 34 + n;
            v4u o; o.x = pg8::pk4_fp8(s[0 * 34], s[1 * 34], s[2 * 34], s[3 * 34]); o.y = pg8::pk4_fp8(s[4 * 34], s[5 * 34], s[6 * 34], s[7 * 34]);
            o.z = pg8::pk4_fp8(s[8 * 34], s[9 * 34], s[10 * 34], s[11 * 34]); o.w = pg8::pk4_fp8(s[12 * 34], s[13 * 34], s[14 * 34], s[15 * 34]);
            *(GAS v4u*)(d.WT + (size_t)(d.drow0 + n) * d.K + d.k0 + 16 * c) = o; }
    } else { const int c = lane & 7;
#pragma unroll
        for (int j = 0; j < 4; ++j) { const int n = (lane >> 3) + 8 * j; const LAS float* s = scr + (8 * c) * 36 + n;
            v4u o; o.x = cvt_pk_bf16(s[0 * 36], s[1 * 36]); o.y = cvt_pk_bf16(s[2 * 36], s[3 * 36]); o.z = cvt_pk_bf16(s[4 * 36], s[5 * 36]); o.w = cvt_pk_bf16(s[6 * 36], s[7 * 36]);
            *(GAS v4u*)(d.WT + ((size_t)(d.drow0 + n) * d.K + d.k0 + 8 * c) * 2) = o; }
    }
    LDS_WAIT(); asm volatile("" ::: "memory");
}
__device__ __forceinline__ void phase_g0(Frame& F) {
    LAS float* scr = (LAS float*)(F.lds + F.wave * 17920);
    const int gw = F.bx * NWAVES + F.wave, NGW = F.G * NWAVES;
    constexpr int IT_WIN = 16 * 209, IT_BG = 16 * 32, IT_BN = 8 * 32, IT_WO = 16 * 32, IT_LAYER = IT_WIN + IT_BG + IT_BN + IT_WO;
    constexpr int IT_FF = 8 * 112, IT_SET = 3 * IT_FF, IT_TOTAL = 4 * IT_LAYER + 18 * IT_SET;
    {
        G0Item cur, nxt; f32x4 tc[16], tn[16];
        int it = gw; bool have = false;
        for (; it < IT_TOTAL; it += NGW) if (g0_decode(F, it, cur)) { have = true; break; }
        if (have) g0_load(cur, F.lane, tc);
        while (have) {
            bool hn = false;
            for (it += NGW; it < IT_TOTAL; it += NGW) if (g0_decode(F, it, nxt)) { hn = true; break; }
            if (hn) g0_load(nxt, F.lane, tn);
            g0_finish(cur, tc, scr, F.lane);
            cur = nxt; have = hn;
#pragma unroll
            for (int i = 0; i < 16; ++i) tc[i] = tn[i];
        }
    }
    {
        const int gt = F.bx * (NWAVES * 64) + F.tid, NGT = F.G * NWAVES * 64;
        for (int it = gt; it < 4 * 2 * 16 * 512; it += NGT) {
            const int n = it & 511, kb = (it >> 9) & 15, dir = (it >> 13) & 1, l = it >> 14;
            const float* w2 = F.in[I_GW2] + ((size_t)(l * 2 + dir) * 16) * 512 + n;
            float w2r[16];
#pragma unroll
            for (int r = 0; r < 16; ++r) w2r[r] = w2[r * 512];
            bf16* dst = WSP(bf16, WS_WIN) + ((size_t)l * NPROJ + 3072 + 512 * dir + n) * D + 64 * kb;
            for (int k8 = 0; k8 < 8; ++k8) {
                float o[8];
#pragma unroll
                for (int kk = 0; kk < 8; ++kk) { const f32x4* a = (const f32x4*)(F.in[I_WIN] + ((size_t)l * D + 64 * kb + 8 * k8 + kk) * DIN + 3072 + 16 * dir); float s = 0.f;
#pragma unroll
                    for (int r4 = 0; r4 < 4; ++r4) { const f32x4 av = a[r4]; s += av.x * w2r[4 * r4] + av.y * w2r[4 * r4 + 1] + av.z * w2r[4 * r4 + 2] + av.w * w2r[4 * r4 + 3]; }
                    o[kk] = s; }
                v4u w; w.x = cvt_pk_bf16(o[0], o[1]); w.y = cvt_pk_bf16(o[2], o[3]); w.z = cvt_pk_bf16(o[4], o[5]); w.w = cvt_pk_bf16(o[6], o[7]);
                *(GAS v4u*)(dst + 8 * k8) = w;
            }
        }
        for (int it = gt; it < 64 * 32; it += NGT) { const int pos = it >> 5, i = it & 31;
            const float inv = exp2f(-(float)i * (13.287712379549449f / 32.0f)); const float rev = (float)pos * inv * 0.15915494309189535f;
            WSP(f32x2, WS_ROPE)[it] = (f32x2){__builtin_amdgcn_cosf(rev), __builtin_amdgcn_sinf(rev)}; }
    }
    __syncthreads();
    {
        LAS float* S = (LAS float*)F.lds;
        LAS float* PS = (LAS float*)(F.lds + 32768);
        { float cv_[10];
#pragma unroll
          for (int k = 0; k < 10; ++k) { const int i = F.tid + 512 * k; cv_[k] = i < 4096 ? ((const GAS float*)F.in[I_C])[i] : ((const GAS float*)F.in[I_CCTX])[i - 4096]; }
#pragma unroll
          for (int k = 0; k < 10; ++k) S[F.tid + 512 * k] = siluf_(cv_[k]); }
        __syncthreads();
        for (int it = F.bx; it < 4 * 192; it += F.G) {
            const int l = it / 192, nb = it % 192;
            const float* W = F.in[I_WMOD] + (size_t)l * D * 6144 + 32 * nb + 4 * (F.lane & 7);
            const int k0 = F.wave * 128 + (F.lane >> 3);
            f32x4 wv[16];
#pragma unroll
            for (int i = 0; i < 16; ++i) wv[i] = *(const f32x4*)(W + (size_t)(k0 + 8 * i) * 6144);
            f32x4 acc[5];
#pragma unroll
            for (int r = 0; r < 5; ++r) acc[r] = (f32x4){0.f, 0.f, 0.f, 0.f};
#pragma unroll
            for (int i = 0; i < 16; ++i)
#pragma unroll
                for (int r = 0; r < 5; ++r) acc[r] += wv[i] * S[r * 1024 + k0 + 8 * i];
#pragma unroll
            for (int r = 0; r < 5; ++r) *(LAS f32x4*)(PS + ((F.wave * 64 + F.lane) * 5 + r) * 4) = acc[r];
            __syncthreads();
            if (F.tid < 160) { const int r = F.tid >> 5, cn = F.tid & 31, cg = cn >> 2, comp = cn & 3; float s = F.in[I_BMOD][l * 6144 + 32 * nb + cn];
                for (int w = 0; w < 8; ++w)
#pragma unroll
                    for (int gq = 0; gq < 8; ++gq) s += PS[((w * 64 + gq * 8 + cg) * 5 + r) * 4 + comp];
                WSP(float, WS_MODS)[(size_t)(l * 5 + r) * 6144 + 32 * nb + cn] = s; }
            __syncthreads();
        }
    }
}

__device__ __forceinline__ void ld_row_f32(const float* p, int lane, f32x4 (&v)[4]) {
#pragma unroll
    for (int j = 0; j < 4; ++j) v[j] = __builtin_nontemporal_load((const GAS f32x4*)(p + 256 * j + 4 * lane));
}
__device__ __forceinline__ void ld_row_bf16(const bf16* p, int lane, f32x4 (&v)[4]) {
#pragma unroll
    for (int j = 0; j < 4; ++j) v[j] = unpack4(*(const v2u*)(p + 256 * j + 4 * lane));
}
__device__ __forceinline__ void st_row_f32(float* p, int lane, const f32x4 (&v)[4]) {
#pragma unroll
    for (int j = 0; j < 4; ++j) __builtin_nontemporal_store(v[j], (f32x4*)(p + 256 * j + 4 * lane));
}
__device__ __forceinline__ void st_row_bf16(bf16* p, int lane, const f32x4 (&v)[4]) {
#pragma unroll
    for (int j = 0; j < 4; ++j) __builtin_nontemporal_store(pack4(v[j]), (v2u*)(p + 256 * j + 4 * lane));
}
__device__ __forceinline__ void ldraw(const bf16* p, int lane, v2u (&v)[4]) {
#pragma unroll
    for (int j = 0; j < 4; ++j) v[j] = __builtin_nontemporal_load((const GAS v2u*)(p + 256 * j + 4 * lane));
}
__device__ __forceinline__ void unraw(const v2u (&v)[4], f32x4 (&o)[4]) {
#pragma unroll
    for (int j = 0; j < 4; ++j) o[j] = unpack4(v[j]);
}
__device__ __forceinline__ float row_rstd(const f32x4 (&v)[4]) { const float ss = (sq4(v[0]) + sq4(v[1])) + (sq4(v[2]) + sq4(v[3])); return rsqrtf(wave_sum(ss) * (1.0f / 1024.0f) + EPS); }
__device__ __forceinline__ void normmod(const f32x4 (&x)[4], const float* g, const float* shift, const float* scale, int lane, f32x4 (&h)[4]) {
    const float rs = row_rstd(x);
#pragma unroll
    for (int j = 0; j < 4; ++j) { const int c = 256 * j + 4 * lane; const f32x4 gv = *(const f32x4*)(g + c), sh = *(const f32x4*)(shift + c), sc = *(const f32x4*)(scale + c);
        h[j] = (x[j] * rs * gv) * (sc + 1.0f) + sh; }
}
#ifndef NS_G1
#define NS_G1 2
#endif
#ifndef NS_GO
#define NS_GO 2
#endif
#ifndef NS_PM
#define NS_PM 2
#endif
template <int NT> __device__ __forceinline__ void stage_tabs(LAS float* TB, const float* const (&src)[NT], const int (&slot)[NT], int tid) {
    if (tid < 256) { f32x4 tv[NT];
#pragma unroll
        for (int k = 0; k < NT; ++k) tv[k] = ((const GAS f32x4*)src[k])[tid];
#pragma unroll
        for (int k = 0; k < NT; ++k) ((LAS f32x4*)(TB + slot[k] * 1024))[tid] = tv[k]; }
}
__device__ __forceinline__ f32x4 tabv(const LAS float* t, int j, int lane) { return *(const LAS f32x4*)(t + 256 * j + 4 * lane); }
__device__ __forceinline__ void normmod_l(const f32x4 (&x)[4], const LAS float* g, const LAS float* shift, const LAS float* scale, int lane, f32x4 (&h)[4]) {
    const float rs = row_rstd(x);
#pragma unroll
    for (int j = 0; j < 4; ++j) h[j] = (x[j] * rs * tabv(g, j, lane)) * (tabv(scale, j, lane) + 1.0f) + tabv(shift, j, lane);
}
__device__ __forceinline__ void cpraw(v2u (&d)[4], const v2u (&s)[4]) {
#pragma unroll
    for (int j = 0; j < 4; ++j) d[j] = s[j];
}
__device__ __forceinline__ void g1_row(Frame& F, int row, const f32x4 (&x)[4], const LAS float* TB) {
    const int mr = row < TL ? (row >> 12) : 4; f32x4 h[4];
    st_row_bf16(WSP(bf16, WS_X) + (size_t)row * D, F.lane, x);
    normmod_l(x, TB, TB + (1 + mr) * 1024, TB + (6 + mr) * 1024, F.lane, h); st_row_bf16(WSP(bf16, WS_H) + (size_t)row * D, F.lane, h);
}
__device__ __forceinline__ void phase_g1(Frame& F) {
    const int gw = F.bx * NWAVES + F.wave, NGW = F.G * NWAVES;
    LAS float* TB = (LAS float*)F.lds;
    { const float* md = WSP(float, WS_MODS);
      const float* const src[11] = {F.in[I_NMPRE], md, md + 6144, md + 2 * 6144, md + 3 * 6144, md + 4 * 6144, md + 1024, md + 6144 + 1024, md + 2 * 6144 + 1024, md + 3 * 6144 + 1024, md + 4 * 6144 + 1024};
      const int slot[11] = {0, 1, 2, 3, 4, 5, 6, 7, 8, 9, 10};
      stage_tabs<11>(TB, src, slot, F.tid); }
    __syncthreads();
#define G1_SRC(row_) ((row_) < TL ? F.in[I_X] + (size_t)(row_) * D : F.in[I_CTX] + (size_t)((row_) - TL) * D)
    f32x4 nr[NS_G1][4];
#pragma unroll
    for (int s = 0; s < NS_G1; ++s) if (gw + s * NGW < T) ld_row_f32(G1_SRC(gw + s * NGW), F.lane, nr[s]);
    for (int row = gw; row < T; row += NS_G1 * NGW) {
        f32x4 cr[NS_G1][4];
#pragma unroll
        for (int s = 0; s < NS_G1; ++s)
#pragma unroll
            for (int j = 0; j < 4; ++j) cr[s][j] = nr[s][j];
#pragma unroll
        for (int s = 0; s < NS_G1; ++s) if (row + (NS_G1 + s) * NGW < T) ld_row_f32(G1_SRC(row + (NS_G1 + s) * NGW), F.lane, nr[s]);
#pragma unroll
        for (int s = 0; s < NS_G1; ++s) if (row + s * NGW < T) g1_row(F, row + s * NGW, cr[s], TB);
    }
#undef G1_SRC
}
#define TROWS(l) ((l) == DEPTH - 1 ? TL : T)
__device__ __forceinline__ void glaout_row(Frame& F, int row, f32x4 (&a)[4], const f32x4 (&b)[4], const f32x4 (&c)[4], const f32x4 (&r)[4], const f32x4 (&gv)[4]) {
#pragma unroll
    for (int j = 0; j < 4; ++j) {
        const f32x4 o = a[j] + b[j] + c[j]; const float rs = rsqrtf(wave_sum(sq4(o)) * (1.0f / 256.0f) + EPS);
        f32x4 y = o * rs * gv[j]; y.x *= siluf_(r[j].x); y.y *= siluf_(r[j].y); y.z *= siluf_(r[j].z); y.w *= siluf_(r[j].w); a[j] = y; }
    st_row_bf16(WSP(bf16, WS_YG) + (size_t)row * D, F.lane, a);
}
__device__ __forceinline__ void phase_gla_out(Frame& F, int l) {
    const int gw = F.bx * NWAVES + F.wave, NGW = F.G * NWAVES, NR = TROWS(l);
    f32x4 gv[4];
#pragma unroll
    for (int j = 0; j < 4; ++j) gv[j] = *(const f32x4*)(F.in[I_GNORM] + l * 1024 + 256 * j + 4 * F.lane);
#define GLAOUT_LOAD(row_, A_, B_, C_, R_) do { ldraw(WSP(bf16, WS_OINTRA) + (size_t)(row_) * D, F.lane, A_); ldraw(WSP(bf16, WS_OIF) + (size_t)(row_) * D, F.lane, B_); ldraw(WSP(bf16, WS_OIB) + (size_t)(row_) * D, F.lane, C_); \
        ldraw(WSP(bf16, WS_PROJ) + (size_t)(row_) * NPROJ + PC_GR, F.lane, R_); } while (0)
    v2u na[NS_GO][4], nb[NS_GO][4], nc[NS_GO][4], nr[NS_GO][4];
#pragma unroll
    for (int s = 0; s < NS_GO; ++s) if (gw + s * NGW < NR) GLAOUT_LOAD(gw + s * NGW, na[s], nb[s], nc[s], nr[s]);
    for (int row = gw; row < NR; row += NS_GO * NGW) {
#pragma unroll
        for (int s = 0; s < NS_GO; ++s) { const int r_ = row + s * NGW;
            if (r_ < NR) { f32x4 a[4], b[4], c[4], r[4]; unraw(na[s], a); unraw(nb[s], b); unraw(nc[s], c); unraw(nr[s], r);
                if (r_ + NS_GO * NGW < NR) GLAOUT_LOAD(r_ + NS_GO * NGW, na[s], nb[s], nc[s], nr[s]);
                glaout_row(F, r_, a, b, c, r, gv); } }
    }
#undef GLAOUT_LOAD
}
__device__ __forceinline__ void pmix_row(Frame& F, int l, int row, f32x4 (&y)[4], f32x4 (&x)[4], const LAS float* TB, const LAS float* WR, LAS unsigned* LCNT, bool moe) {
    const int mr = row < TL ? (row >> 12) : 4;
    f32x4 h[4];
    if (row >= TL) {
        const bf16* yc = WSP(bf16, WS_YC) + (size_t)(row - TL) * D;
        { v2u sl[6][4];
#pragma unroll
          for (int ks = 0; ks < 6; ++ks) ldraw(yc + (size_t)(ks + 1) * TC * D, F.lane, sl[ks]);
#pragma unroll
          for (int ks = 0; ks < 6; ++ks) { f32x4 y2[4]; unraw(sl[ks], y2);
#pragma unroll
              for (int j = 0; j < 4; ++j) y[j] += y2[j]; } }
        { v2u sl[5][4];
#pragma unroll
          for (int ks = 0; ks < 5; ++ks) ldraw(yc + (size_t)(ks + 7) * TC * D, F.lane, sl[ks]);
#pragma unroll
          for (int ks = 0; ks < 5; ++ks) { f32x4 y2[4]; unraw(sl[ks], y2);
#pragma unroll
              for (int j = 0; j < 4; ++j) y[j] += y2[j]; } } }
    const float rs = row_rstd(y);
#pragma unroll
    for (int j = 0; j < 4; ++j) x[j] += tabv(TB + mr * 1024, j, F.lane) * (y[j] * rs * tabv(TB + 5 * 1024, j, F.lane));
    st_row_bf16(WSP(bf16, WS_X) + (size_t)row * D, F.lane, x);
    normmod_l(x, TB + 6 * 1024, TB + (7 + mr) * 1024, TB + (12 + mr) * 1024, F.lane, h);
    if (DENSE_FP8 || moe) { unsigned char* h8 = WSP(unsigned char, WS_H) + (size_t)row * D;
#pragma unroll
      for (int j = 0; j < 4; ++j) __builtin_nontemporal_store(pg8::pk4_fp8(h[j].x, h[j].y, h[j].z, h[j].w), (unsigned*)(h8 + 256 * j + 4 * F.lane)); }
    else st_row_bf16(WSP(bf16, WS_H) + (size_t)row * D, F.lane, h);
    if (moe) {
        float lg[8] = {0.f, 0.f, 0.f, 0.f, 0.f, 0.f, 0.f, 0.f};
#pragma unroll
        for (int j = 0; j < 4; ++j)
#pragma unroll
            for (int i = 0; i < 4; ++i) { const LAS f32x4* w = (const LAS f32x4*)(WR + ((j * 4 + i) * 64 + F.lane) * 8); const f32x4 w0 = w[0], w1 = w[1]; const float hv = h[j][i];
                lg[0] += hv * w0.x; lg[1] += hv * w0.y; lg[2] += hv * w0.z; lg[3] += hv * w0.w; lg[4] += hv * w1.x; lg[5] += hv * w1.y; lg[6] += hv * w1.z; lg[7] += hv * w1.w; }
#pragma unroll
        for (int e = 0; e < 8; ++e) lg[e] = wave_sum(lg[e]);
        int i1 = 0; float v1 = lg[0];
#pragma unroll
        for (int e = 1; e < 8; ++e) if (lg[e] > v1) { v1 = lg[e]; i1 = e; }
        int i2 = -1; float v2 = -3.0e38f;
#pragma unroll
        for (int e = 0; e < 8; ++e) if (e != i1 && lg[e] > v2) { v2 = lg[e]; i2 = e; }
        const float e2 = __expf(v2 - v1), inv = 1.0f / (1.0f + e2);
        if (F.lane == 0) {
            WSP(f32x2, WS_WT)[row] = (f32x2){inv, e2 * inv};
            (void)__hip_atomic_fetch_add(LCNT + i1, 1u, __ATOMIC_RELAXED, __HIP_MEMORY_SCOPE_WORKGROUP); (void)__hip_atomic_fetch_add(LCNT + i2, 1u, __ATOMIC_RELAXED, __HIP_MEMORY_SCOPE_WORKGROUP);
            WSP(int, WS_SLOT)[2 * (size_t)row] = i1; WSP(int, WS_SLOT)[2 * (size_t)row + 1] = i2;
        }
    }
}
__device__ __forceinline__ void phase_post_mix(Frame& F, int l) {
    const int gw = F.bx * NWAVES + F.wave, NGW = F.G * NWAVES, NR = TROWS(l); const bool moe = (l & 1) != 0;
    LAS float* TB = (LAS float*)F.lds;
    LAS float* WR = (LAS float*)(F.lds + 17 * 4096);
    LAS unsigned* LCNT = (LAS unsigned*)(F.lds + 17 * 4096 + 32768);
    { const float* md = WSP(float, WS_MODS) + (size_t)(l * 5) * 6144;
      const float* const src[17] = {md + 2048, md + 6144 + 2048, md + 2 * 6144 + 2048, md + 3 * 6144 + 2048, md + 4 * 6144 + 2048, F.in[I_NMPOST] + l * 1024, F.in[I_NFPRE] + l * 1024,
          md + 3072, md + 6144 + 3072, md + 2 * 6144 + 3072, md + 3 * 6144 + 3072, md + 4 * 6144 + 3072, md + 4096, md + 6144 + 4096, md + 2 * 6144 + 4096, md + 3 * 6144 + 4096, md + 4 * 6144 + 4096};
      const int slot[17] = {0, 1, 2, 3, 4, 5, 6, 7, 8, 9, 10, 11, 12, 13, 14, 15, 16};
      stage_tabs<17>(TB, src, slot, F.tid); }
    if (moe) { const float* wr = F.in[I_ROUTER] + (size_t)(l >> 1) * D * NEXP;
        for (int c = F.tid; c < D; c += NWAVES * 64) { const int j = c >> 8, ln = (c >> 2) & 63, i = c & 3; LAS f32x4* dst = (LAS f32x4*)(WR + ((j * 4 + i) * 64 + ln) * 8); const f32x4* src = (const f32x4*)(wr + (size_t)c * 8); dst[0] = src[0]; dst[1] = src[1]; }
        if (F.tid < 16) LCNT[F.tid] = 0u; }
#define PMIX_LOAD(row_, Y_, X_) do { ldraw((row_) < TL ? WSP(bf16, WS_Y) + (size_t)(row_) * D : WSP(bf16, WS_YC) + (size_t)((row_) - TL) * D, F.lane, Y_); ldraw(WSP(bf16, WS_X) + (size_t)(row_) * D, F.lane, X_); } while (0)
    v2u ny[NS_PM][4], nx[NS_PM][4];
#pragma unroll
    for (int s = 0; s < NS_PM; ++s) if (gw + s * NGW < NR) PMIX_LOAD(gw + s * NGW, ny[s], nx[s]);
    __syncthreads();
    for (int row = gw; row < NR; row += NS_PM * NGW) {
#pragma unroll
        for (int s = 0; s < NS_PM; ++s) { const int r_ = row + s * NGW;
            if (r_ < NR) { f32x4 y[4], x[4]; unraw(ny[s], y); unraw(nx[s], x);
                if (r_ + NS_PM * NGW < NR) PMIX_LOAD(r_ + NS_PM * NGW, ny[s], nx[s]);
                pmix_row(F, l, r_, y, x, TB, WR, LCNT, moe); } }
    }
#undef PMIX_LOAD
    if (moe) {
        __syncthreads();
        if (F.tid < 8) { const unsigned cv = LCNT[F.tid]; WSP(int, WS_CNTW)[F.bx * 8 + F.tid] = (int)cv;
            (void)__hip_atomic_fetch_add((unsigned*)(F.ws + WS_CTL) + CW_MOE + 64 * (l >> 1) + F.tid, cv, __ATOMIC_RELAXED, __HIP_MEMORY_SCOPE_AGENT); }
    }
}
__device__ __forceinline__ void moe_counts(Frame& F, int j, int (&cnt)[8]) {
    unsigned v[8];
#pragma unroll
    for (int e = 0; e < 8; ++e) v[e] = __hip_atomic_load((unsigned*)(F.ws + WS_CTL) + CW_MOE + 64 * j + e, __ATOMIC_RELAXED, __HIP_MEMORY_SCOPE_AGENT);
    asm volatile("" ::: "memory");
#pragma unroll
    for (int e = 0; e < 8; ++e) cnt[e] = __builtin_amdgcn_readfirstlane((int)v[e]);
}
constexpr int MOE_SL_ROWS = 16 * 256;
__device__ __forceinline__ int moe_split_tile(const int (&cnt)[8], int G) {
    int nt = 0;
#pragma unroll
    for (int e = 0; e < 8; ++e) nt += (cnt[e] + 255) >> 8;
    int s = (4 * nt - 2 * G + 3) >> 2; s = s < 0 ? 0 : (s > 15 ? 15 : s);
    return (4 * nt <= 2 * G || 4 * nt > 3 * G) ? nt : nt - s;
}
__device__ __forceinline__ void phase_moe_gather(Frame& F, int l) {
    const int gw = F.bx * NWAVES + F.wave, NGW = F.G * NWAVES, NR = TROWS(l);
    LAS int* CW = (LAS int*)F.lds;
    LAS int* BASE = (LAS int*)(F.lds + 16384);
    LAS int* TE = (LAS int*)(F.lds + 16384 + 128);
    v4u ar[9];
#pragma unroll
    for (int k = 0; k < 9; ++k) { const int row = gw + k * NGW; if (row < NR) ar[k] = __builtin_nontemporal_load((const GAS v4u*)(WSP(unsigned char, WS_H) + (size_t)row * D) + F.lane); }
    { int cv_[4];
#pragma unroll
      for (int k = 0; k < 4; ++k) { const int i = F.tid + 512 * k; cv_[k] = i < F.G * 8 ? ((const GAS int*)WSP(int, WS_CNTW))[i] : 0; }
#pragma unroll
      for (int k = 0; k < 4; ++k) { const int i = F.tid + 512 * k; if (i < F.G * 8) CW[i] = cv_[k]; } }
    if (F.lane < 9) { const int row = gw + F.lane * NGW; int e1 = -1, e2 = -1; if (row < NR) { e1 = WSP(int, WS_SLOT)[2 * (size_t)row]; e2 = WSP(int, WS_SLOT)[2 * (size_t)row + 1]; }
        TE[(F.wave * 9 + F.lane) * 2] = e1; TE[(F.wave * 9 + F.lane) * 2 + 1] = e2; }
    __syncthreads();
    { const int e = F.wave; float tot = 0.f, below = 0.f;
      for (int wgi = F.lane; wgi < F.G; wgi += 64) { const float cv = (float)CW[wgi * 8 + e]; tot += cv; below += wgi < F.bx ? cv : 0.f; }
      tot = wave_sum(tot); below = wave_sum(below);
      if (F.lane == 0) { BASE[e] = (int)below; BASE[16 + e] = (int)tot; } }
    __syncthreads();
    if (F.tid == 0) { int o = 0; for (int e = 0; e < 8; ++e) { BASE[8 + e] = o; o += ((BASE[16 + e] + 255) >> 8) << 8; } }
    __syncthreads();
    const int sl0 = F.lane, sl1 = F.lane + 64;
    const int t0a = TE[sl0 * 2], t0b = TE[sl0 * 2 + 1]; const int t1a = sl1 < 72 ? TE[sl1 * 2] : -1, t1b = sl1 < 72 ? TE[sl1 * 2 + 1] : -1;
#pragma unroll
    for (int k = 0; k < 9; ++k) { const int row = gw + k * NGW;
        if (row < NR) {
            const int me = F.wave * 9 + k; const int e1 = TE[me * 2], e2 = TE[me * 2 + 1];
            const int r1 = __popcll(__ballot((sl0 < me) && (t0a == e1 || t0b == e1))) + __popcll(__ballot((sl1 < me) && (t1a == e1 || t1b == e1)));
            const int r2 = __popcll(__ballot((sl0 < me) && (t0a == e2 || t0b == e2))) + __popcll(__ballot((sl1 < me) && (t1a == e2 || t1b == e2)));
            const int d1 = BASE[8 + e1] + BASE[e1] + r1, d2 = BASE[8 + e2] + BASE[e2] + r2;
            __builtin_nontemporal_store(ar[k], (v4u*)(WSP(unsigned char, WS_XG) + (size_t)d1 * D) + F.lane); __builtin_nontemporal_store(ar[k], (v4u*)(WSP(unsigned char, WS_XG) + (size_t)d2 * D) + F.lane);
            if (F.lane == 0) { WSP(int, WS_DEST)[2 * (size_t)row] = d1; WSP(int, WS_DEST)[2 * (size_t)row + 1] = d2; } } }
}
__device__ __forceinline__ void pffn_row(Frame& F, int l, int row, f32x4 (&f)[4], f32x4 (&f2)[4], f32x4 (&x)[4], int d1c, int d2c, f32x2 wt, int srow, bool moe, const LAS float* TB) {
    const int mr = row < TL ? (row >> 12) : 4;
    f32x4 h[4];
    if (moe) {
        if (d1c >= srow) {
            v2u sl[6][4];
#pragma unroll
            for (int ks = 0; ks < 6; ++ks) ldraw(WSP(bf16, WS_XG) + ((size_t)(ks + 1) * MOE_SL_ROWS + (d1c - srow)) * D, F.lane, sl[ks]);
#pragma unroll
            for (int ks = 0; ks < 6; ++ks) { f32x4 t[4]; unraw(sl[ks], t);
#pragma unroll
                for (int j = 0; j < 4; ++j) f[j] += t[j]; } }
        if (d2c >= srow) {
            v2u sl[6][4];
#pragma unroll
            for (int ks = 0; ks < 6; ++ks) ldraw(WSP(bf16, WS_XG) + ((size_t)(ks + 1) * MOE_SL_ROWS + (d2c - srow)) * D, F.lane, sl[ks]);
#pragma unroll
            for (int ks = 0; ks < 6; ++ks) { f32x4 t[4]; unraw(sl[ks], t);
#pragma unroll
                for (int j = 0; j < 4; ++j) f2[j] += t[j]; } }
#pragma unroll
        for (int j = 0; j < 4; ++j) f[j] = f[j] * wt.x + f2[j] * wt.y; }
    if (!moe && row >= TL) {
        v2u sl[6][4];
#pragma unroll
        for (int ks = 0; ks < 6; ++ks) ldraw(WSP(bf16, WS_FC) + ((size_t)(ks + 1) * TC + (row - TL)) * D, F.lane, sl[ks]);
#pragma unroll
        for (int ks = 0; ks < 6; ++ks) { f32x4 t[4]; unraw(sl[ks], t);
#pragma unroll
            for (int j = 0; j < 4; ++j) f[j] += t[j]; } }
    const float rs = row_rstd(f);
#pragma unroll
    for (int j = 0; j < 4; ++j) x[j] += tabv(TB + mr * 1024, j, F.lane) * (f[j] * rs * tabv(TB + 5 * 1024, j, F.lane));
    if (l == DEPTH - 1) { st_row_f32(F.out + (size_t)row * D, F.lane, x); return; }
    st_row_bf16(WSP(bf16, WS_X) + (size_t)row * D, F.lane, x);
    normmod_l(x, TB + 6 * 1024, TB + (7 + mr) * 1024, TB + (12 + mr) * 1024, F.lane, h); st_row_bf16(WSP(bf16, WS_H) + (size_t)row * D, F.lane, h);
}
__device__ __forceinline__ void phase_post_ffn(Frame& F, int l) {
    const int gw = F.bx * NWAVES + F.wave, NGW = F.G * NWAVES, NR = TROWS(l); const bool moe = (l & 1) != 0;
    LAS float* TB = (LAS float*)F.lds;
    { const float* md = WSP(float, WS_MODS) + (size_t)(l * 5) * 6144;
      if (l < DEPTH - 1) { const float* m2 = md + 5 * 6144;
          const float* const src[17] = {md + 5120, md + 6144 + 5120, md + 2 * 6144 + 5120, md + 3 * 6144 + 5120, md + 4 * 6144 + 5120, F.in[I_NFPOST] + l * 1024, F.in[I_NMPRE] + (l + 1) * 1024,
              m2, m2 + 6144, m2 + 2 * 6144, m2 + 3 * 6144, m2 + 4 * 6144, m2 + 1024, m2 + 6144 + 1024, m2 + 2 * 6144 + 1024, m2 + 3 * 6144 + 1024, m2 + 4 * 6144 + 1024};
          const int slot[17] = {0, 1, 2, 3, 4, 5, 6, 7, 8, 9, 10, 11, 12, 13, 14, 15, 16};
          stage_tabs<17>(TB, src, slot, F.tid); }
      else { const float* const src[6] = {md + 5120, md + 6144 + 5120, md + 2 * 6144 + 5120, md + 3 * 6144 + 5120, md + 4 * 6144 + 5120, F.in[I_NFPOST] + l * 1024};
          const int slot[6] = {0, 1, 2, 3, 4, 5};
          stage_tabs<6>(TB, src, slot, F.tid); } }
    int srow = 0x7fffffff;
    if (moe) { int cnt[8]; moe_counts(F, l >> 1, cnt); srow = moe_split_tile(cnt, F.G) * 256; }
#define PFFN_IDX(row_, D1_, D2_, W_) do { if (moe) { D1_ = WSP(int, WS_DEST)[2 * (size_t)(row_)]; D2_ = WSP(int, WS_DEST)[2 * (size_t)(row_) + 1]; W_ = WSP(f32x2, WS_WT)[(row_)]; } } while (0)
#define PFFN_ROWS(row_, D1_, D2_, RF_, RG_, RX_) do { if (moe) { \
            ldraw(D1_ < srow ? WSP(bf16, WS_FS) + (size_t)D1_ * D : WSP(bf16, WS_XG) + (size_t)(D1_ - srow) * D, F.lane, RF_); ldraw(D2_ < srow ? WSP(bf16, WS_FS) + (size_t)D2_ * D : WSP(bf16, WS_XG) + (size_t)(D2_ - srow) * D, F.lane, RG_); } \
        else ldraw((row_) < TL ? WSP(bf16, WS_FS) + (size_t)(row_) * D : WSP(bf16, WS_FC) + (size_t)((row_) - TL) * D, F.lane, RF_); \
        ldraw(WSP(bf16, WS_X) + (size_t)(row_) * D, F.lane, RX_); } while (0)
    int nd1_0 = 0, nd2_0 = 0, nd1_1 = 0, nd2_1 = 0, fd1_0 = 0, fd2_0 = 0, fd1_1 = 0, fd2_1 = 0;
    float one_ = 1.0f; asm volatile("" : "+v"(one_));
    f32x2 nw_0 = (f32x2){one_, 0.f}, nw_1 = nw_0, fw_0 = nw_0, fw_1 = nw_0;
    v2u nf0[4], ng0[4], nx0[4], nf1[4], ng1[4], nx1[4];
#pragma unroll
    for (int j = 0; j < 4; ++j) { ng0[j] = (v2u){0u, 0u}; ng1[j] = (v2u){0u, 0u}; }
    if (gw < NR) PFFN_IDX(gw, nd1_0, nd2_0, nw_0);
    if (gw + NGW < NR) PFFN_IDX(gw + NGW, nd1_1, nd2_1, nw_1);
    if (gw < NR) PFFN_ROWS(gw, nd1_0, nd2_0, nf0, ng0, nx0);
    if (gw + NGW < NR) PFFN_ROWS(gw + NGW, nd1_1, nd2_1, nf1, ng1, nx1);
    if (gw + 2 * NGW < NR) PFFN_IDX(gw + 2 * NGW, fd1_0, fd2_0, fw_0);
    if (gw + 3 * NGW < NR) PFFN_IDX(gw + 3 * NGW, fd1_1, fd2_1, fw_1);
    __syncthreads();
    for (int row = gw; row < NR; row += 2 * NGW) {
        { f32x4 f[4], f2[4], x[4]; unraw(nf0, f); unraw(ng0, f2); unraw(nx0, x); const int cd1 = nd1_0, cd2 = nd2_0; const f32x2 cw = nw_0;
          if (row + 2 * NGW < NR) { nd1_0 = fd1_0; nd2_0 = fd2_0; nw_0 = fw_0; PFFN_ROWS(row + 2 * NGW, nd1_0, nd2_0, nf0, ng0, nx0); }
          if (row + 4 * NGW < NR) PFFN_IDX(row + 4 * NGW, fd1_0, fd2_0, fw_0);
          pffn_row(F, l, row, f, f2, x, cd1, cd2, cw, srow, moe, TB); }
        if (row + NGW < NR) { f32x4 f[4], f2[4], x[4]; unraw(nf1, f); unraw(ng1, f2); unraw(nx1, x); const int cd1 = nd1_1, cd2 = nd2_1; const f32x2 cw = nw_1;
          if (row + 3 * NGW < NR) { nd1_1 = fd1_1; nd2_1 = fd2_1; nw_1 = fw_1; PFFN_ROWS(row + 3 * NGW, nd1_1, nd2_1, nf1, ng1, nx1); }
          if (row + 5 * NGW < NR) PFFN_IDX(row + 5 * NGW, fd1_1, fd2_1, fw_1);
          pffn_row(F, l, row + NGW, f, f2, x, cd1, cd2, cw, srow, moe, TB); }
    }
#undef PFFN_IDX
#undef PFFN_ROWS
}

typedef short bf16x8v __attribute__((ext_vector_type(8)));
#define MFMA16(a, b, c) __builtin_amdgcn_mfma_f32_16x16x32_bf16((a), (b), (c), 0, 0, 0)
__device__ __forceinline__ bf16 f2bf1(float x) { return (bf16)(cvt_pk_bf16(x, 0.f) & 0xffffu); }
__device__ __forceinline__ void unpack8(v4u w, float* o) { o[0] = bflo(w.x); o[1] = bfhi(w.x); o[2] = bflo(w.y); o[3] = bfhi(w.y); o[4] = bflo(w.z); o[5] = bfhi(w.z); o[6] = bflo(w.w); o[7] = bfhi(w.w); }
__device__ __forceinline__ float dpp_scan64(float v) {
    v += __builtin_bit_cast(float, __builtin_amdgcn_update_dpp(0, __builtin_bit_cast(int, v), 0x111, 0xf, 0xf, true));
    v += __builtin_bit_cast(float, __builtin_amdgcn_update_dpp(0, __builtin_bit_cast(int, v), 0x112, 0xf, 0xf, true));
    v += __builtin_bit_cast(float, __builtin_amdgcn_update_dpp(0, __builtin_bit_cast(int, v), 0x114, 0xf, 0xf, true));
    v += __builtin_bit_cast(float, __builtin_amdgcn_update_dpp(0, __builtin_bit_cast(int, v), 0x118, 0xf, 0xf, true));
    v += __builtin_bit_cast(float, __builtin_amdgcn_update_dpp(0, __builtin_bit_cast(int, v), 0x142, 0xa, 0xf, false));
    v += __builtin_bit_cast(float, __builtin_amdgcn_update_dpp(0, __builtin_bit_cast(int, v), 0x143, 0xc, 0xf, false));
    return v;
}
__device__ __forceinline__ void gla_prep(Frame& F, int l) {
    const bf16* P = WSP(bf16, WS_PROJ); const f32x2* rope = WSP(f32x2, WS_ROPE);
    LAS unsigned char* L = F.lds;
    constexpr int L_QE0 = 0, L_KE0 = 17408, L_VT = 69632, L_P = 106496;
    const int lane = F.lane, w = F.wave, g = lane >> 4, lr = lane & 15;
    v4u pf[12];
#define GLA_PREP_LOAD(it_) do { const int ck_ = (it_) % 68, bh_ = (it_) / 68, h_ = bh_ & 3, b_ = bh_ >> 2; const int r0_ = ck_ < 4 ? TL + b_ * CTX + 64 * ck_ : b_ * SEQ + 64 * (ck_ - 4); \
        const bf16* pr0_ = P + (size_t)r0_ * NPROJ; \
        _Pragma("unroll") for (int i_ = 0; i_ < 4; ++i_) { const int p_ = F.tid + 512 * i_; pf[i_] = __builtin_nontemporal_load((const GAS v4u*)(pr0_ + (size_t)(p_ >> 5) * NPROJ + PC_GV + h_ * 256 + 8 * (p_ & 31))); } \
        _Pragma("unroll") for (int i_ = 0; i_ < 2; ++i_) { const int p_ = F.tid + 512 * i_; const bf16* rp_ = pr0_ + (size_t)(p_ >> 4) * NPROJ + h_ * 128 + 8 * (p_ & 15); \
            pf[4 + i_] = __builtin_nontemporal_load((const GAS v4u*)(rp_ + PC_GQ)); pf[6 + i_] = __builtin_nontemporal_load((const GAS v4u*)(rp_ + PC_GK)); pf[8 + i_] = __builtin_nontemporal_load((const GAS v4u*)(rp_ + PC_ZF)); pf[10 + i_] = __builtin_nontemporal_load((const GAS v4u*)(rp_ + PC_ZB)); } } while (0)
    constexpr int L_ROPE = 115712, L_GBL = L_ROPE + 64 * 272;
    { f32x2 rv_[4]; float gv_[2];
#pragma unroll
      for (int k = 0; k < 4; ++k) rv_[k] = ((const GAS f32x2*)rope)[F.tid + 512 * k];
#pragma unroll
      for (int k = 0; k < 2; ++k) gv_[k] = ((const GAS float*)(F.in[I_GB] + (size_t)l * 1024))[F.tid + 512 * k];
#pragma unroll
      for (int k = 0; k < 4; ++k) { const int i = F.tid + 512 * k; *(LAS f32x2*)(L + L_ROPE + (i >> 5) * 272 + (i & 31) * 8) = rv_[k]; }
#pragma unroll
      for (int k = 0; k < 2; ++k) ((LAS float*)(L + L_GBL))[F.tid + 512 * k] = gv_[k]; }
    if (F.bx < 1088) GLA_PREP_LOAD(F.bx);
    __syncthreads();
    for (int item = F.bx; item < 1088; item += F.G) {
        const int ck = item % 68, bh = item / 68, h = bh & 3, b = bh >> 2;
        const bool isctx = ck < 4;
        const int row0 = isctx ? TL + b * CTX + 64 * ck : b * SEQ + 64 * (ck - 4);
        unsigned char* gblk0 = F.ws + WS_GBLK + (size_t)((bh * 2 + 0) * 68 + ck) * GB_BYTES;
#pragma unroll
        for (int i = 0; i < 4; ++i) { const int p = F.tid + 512 * i; *(LAS v4u*)(L + (p >> 5) * 528 + 16 * (p & 31)) = pf[i]; }
#pragma unroll
        for (int i = 0; i < 2; ++i) { const int p = F.tid + 512 * i; const int o = (p >> 4) * 272 + 16 * (p & 15);
            *(LAS v4u*)(L + L_VT + o) = pf[4 + i]; *(LAS v4u*)(L + L_VT + 17408 + o) = pf[6 + i]; *(LAS v4u*)(L + 34816 + o) = pf[8 + i]; *(LAS v4u*)(L + 52224 + o) = pf[10 + i]; }
        { const int nitem = item + F.G; if (nitem < 1088) GLA_PREP_LOAD(nitem); }
        __syncthreads();
        float qv[16], kv[16]; v4u vraw[4], zraw[4];
        { const LAS v4u* qp = (const LAS v4u*)(L + L_VT + lane * 272 + 32 * w); const LAS v4u* kp = (const LAS v4u*)(L + L_VT + 17408 + lane * 272 + 32 * w);
          unpack8(qp[0], qv); unpack8(qp[1], qv + 8); unpack8(kp[0], kv); unpack8(kp[1], kv + 8);
          const LAS v4u* zf = (const LAS v4u*)(L + 34816 + lane * 272 + 32 * w); const LAS v4u* zb = (const LAS v4u*)(L + 52224 + lane * 272 + 32 * w);
          zraw[0] = zf[0]; zraw[1] = zf[1]; zraw[2] = zb[0]; zraw[3] = zb[1];
#pragma unroll
          for (int c4 = 0; c4 < 4; ++c4) vraw[c4] = *(const LAS v4u*)(L + lane * 528 + 64 * w + 16 * c4); }
        if (!isctx) {
            float qq[16], kk[16];
            { const LAS v4u* qp = (const LAS v4u*)(L + L_VT + lane * 272 + 32 * (w ^ 2)); const LAS v4u* kp = (const LAS v4u*)(L + L_VT + 17408 + lane * 272 + 32 * (w ^ 2));
              unpack8(qp[0], qq); unpack8(qp[1], qq + 8); unpack8(kp[0], kk); unpack8(kp[1], kk + 8); }
            const int s = 64 * (ck - 4) + lane; const int pos = (w >= 4) ? (s & 63) : (s >> 6); const bool second = ((w >> 1) & 1) != 0;
#pragma unroll
            for (int i = 0; i < 16; ++i) { const f32x2 cs = *(const LAS f32x2*)(L + L_ROPE + pos * 272 + (16 * (w & 1) + i) * 8);
                if (second) { qv[i] = qq[i] * cs.y + qv[i] * cs.x; kv[i] = kk[i] * cs.y + kv[i] * cs.x; }
                else { qv[i] = qv[i] * cs.x - qq[i] * cs.y; kv[i] = kv[i] * cs.x - kk[i] * cs.y; } }
        }
#pragma unroll
        for (int i = 0; i < 16; ++i) qv[i] *= 0.08838834764831845f;
        __syncthreads();
#pragma unroll
        for (int dir = 0; dir < 2; ++dir) {
            float lg[16], own[16];
            unpack8(zraw[2 * dir], lg); unpack8(zraw[2 * dir + 1], lg + 8);
            const LAS float* gbias = (const LAS float*)(L + L_GBL) + dir * 512 + h * 128 + 16 * w;
#pragma unroll
            for (int i = 0; i < 16; ++i) { const float z2 = (lg[i] + gbias[i]) * 1.4426950408889634f;
                lg[i] = -(fmaxf(-z2, 0.f) + __builtin_amdgcn_logf(1.0f + __builtin_amdgcn_exp2f(-fabsf(z2)))) * 0.0625f; own[i] = lg[i]; }
#pragma unroll
            for (int i = 0; i < 16; ++i) lg[i] = dpp_scan64(lg[i]);
            float tot[16];
#pragma unroll
            for (int i = 0; i < 16; ++i) tot[i] = __int_as_float(__builtin_amdgcn_readlane(__float_as_int(lg[i]), 63));
            if (dir) {
#pragma unroll
                for (int i = 0; i < 16; ++i) lg[i] = tot[i] - lg[i] + own[i];
            }
            float dect[16];
#pragma unroll
            for (int i = 0; i < 16; ++i) dect[i] = __builtin_amdgcn_exp2f(tot[i]);
            unsigned char* gblk = gblk0 + (size_t)dir * 68 * GB_BYTES;
            LAS unsigned char* qe_t = L + L_QE0 + dir * 34816 + lane * 272 + (32 * (w >> 1) + 4 * (w & 1)) * 2;
            LAS unsigned char* ke_t = L + L_KE0 + dir * 34816 + lane * 272 + (32 * (w >> 1) + 4 * (w & 1)) * 2;
            bf16* kdt = (bf16*)(gblk + GB_KDT) + lane;
#pragma unroll
            for (int gg = 0; gg < 4; ++gg) {
                float qe[4], ke[4];
#pragma unroll
                for (int j = 0; j < 4; ++j) { const int i = 4 * gg + j; const float eb = __builtin_amdgcn_exp2f(lg[i]); qe[j] = qv[i] * eb; ke[j] = kv[i] * __builtin_amdgcn_rcpf(eb);
                    kdt[(16 * w + i) * 72] = f2bf1(ke[j] * dect[i]); }
                v2u a; a.x = cvt_pk_bf16(qe[0], qe[1]); a.y = cvt_pk_bf16(qe[2], qe[3]); *(LAS v2u*)(qe_t + 16 * gg) = a;
                v2u c; c.x = cvt_pk_bf16(ke[0], ke[1]); c.y = cvt_pk_bf16(ke[2], ke[3]); *(LAS v2u*)(ke_t + 16 * gg) = c;
            }
            if (lane == 0) { float* dp = (float*)(gblk + GB_DEC) + 16 * w;
#pragma unroll
                for (int i4 = 0; i4 < 4; ++i4) *(f32x4*)(dp + 4 * i4) = (f32x4){dect[4 * i4], dect[4 * i4 + 1], dect[4 * i4 + 2], dect[4 * i4 + 3]}; }
        }
        { LAS unsigned char* vt = L + L_VT + 2 * (lane & ~1); const bool odd = (lane & 1) != 0;
#pragma unroll
          for (int c4 = 0; c4 < 4; ++c4) { const v4u x = vraw[c4]; const int v0 = 32 * w + 8 * c4;
#pragma unroll
              for (int m = 0; m < 4; ++m) { const unsigned xm = m == 0 ? x.x : (m == 1 ? x.y : (m == 2 ? x.z : x.w)); const unsigned ym = (unsigned)__shfl_xor((int)xm, 1);
                  const unsigned out = odd ? ((ym >> 16) | (xm & 0xffff0000u)) : ((xm & 0xffffu) | (ym << 16));
                  *(LAS unsigned*)(vt + (v0 + 2 * m + (odd ? 1 : 0)) * 144) = out; } } }
        __syncthreads();
        { const int tt = w >> 1, st0 = (w & 1) * 2;
          f32x4 pacc[2] = {(f32x4){0.f, 0.f, 0.f, 0.f}, (f32x4){0.f, 0.f, 0.f, 0.f}};
#pragma unroll
          for (int dir = 0; dir < 2; ++dir)
#pragma unroll
              for (int sti = 0; sti < 2; ++sti) { f32x4 acc = (f32x4){0.f, 0.f, 0.f, 0.f};
#pragma unroll
                  for (int ks = 0; ks < 4; ++ks) { const bf16x8v a = *(const LAS bf16x8v*)(L + L_QE0 + dir * 34816 + (16 * tt + lr) * 272 + (32 * ks + 8 * g) * 2);
                      const bf16x8v bb = *(const LAS bf16x8v*)(L + L_KE0 + dir * 34816 + (16 * (st0 + sti) + lr) * 272 + (32 * ks + 8 * g) * 2); acc = MFMA16(a, bb, acc); }
#pragma unroll
                  for (int r = 0; r < 4; ++r) { const int t = 16 * tt + 4 * g + r, s = 16 * (st0 + sti) + lr; const bool keep = dir ? (s >= t) : (s <= t); pacc[sti][r] += keep ? acc[r] : 0.f; } }
          { const bool odd = (lane & 1) != 0;
#pragma unroll
            for (int sti = 0; sti < 2; ++sti) { float q[4];
#pragma unroll
                for (int r = 0; r < 4; ++r) q[r] = __shfl_xor(pacc[sti][r], 1);
#pragma unroll
                for (int rr = 0; rr < 2; ++rr) { const int r = 2 * rr + (odd ? 1 : 0); const float mine = odd ? (rr ? pacc[sti][3] : pacc[sti][1]) : (rr ? pacc[sti][2] : pacc[sti][0]), oth = odd ? (rr ? q[3] : q[1]) : (rr ? q[2] : q[0]);
                    const unsigned out = odd ? cvt_pk_bf16(oth, mine) : cvt_pk_bf16(mine, oth);
                    *(LAS unsigned*)(L + L_P + (16 * tt + 4 * g + r) * 144 + 2 * (16 * (st0 + sti) + (lr & ~1))) = out; } } }
#pragma unroll
          for (int dir = 0; dir < 2; ++dir)
              for (int c = F.tid; c < 1088; c += NWAVES * 64) *(v4u*)(gblk0 + (size_t)dir * 68 * GB_BYTES + GB_QE + 16 * c) = *(const LAS v4u*)(L + L_QE0 + dir * 34816 + 16 * c);
        }
        __syncthreads();
        { bf16* oi = WSP(bf16, WS_OINTRA);
#pragma unroll
          for (int vti = 0; vti < 2; ++vti) { const int vt = 2 * w + vti;
#pragma unroll
              for (int tt = 0; tt < 4; ++tt) { f32x4 acc = (f32x4){0.f, 0.f, 0.f, 0.f};
#pragma unroll
                  for (int ks = 0; ks < 2; ++ks) { const bf16x8v a = *(const LAS bf16x8v*)(L + L_VT + (16 * vt + lr) * 144 + (32 * ks + 8 * g) * 2);
                      const bf16x8v bb = *(const LAS bf16x8v*)(L + L_P + (16 * tt + lr) * 144 + (32 * ks + 8 * g) * 2); acc = MFMA16(a, bb, acc); }
                  *(v2u*)(oi + (size_t)(row0 + 16 * tt + lr) * D + h * 256 + 16 * vt + 4 * g) = pack4(acc); } }
          unsigned char* vtb = F.ws + WS_VTB + (size_t)(bh * 68 + ck) * VT_BYTES;
          for (int c = F.tid; c < 2304; c += NWAVES * 64) *(v4u*)(vtb + 16 * c) = *(const LAS v4u*)(L + L_VT + 16 * c);
        }
        __syncthreads();
    }
}
template <int CTRL> __device__ __forceinline__ float dppf(float v) { return __builtin_bit_cast(float, __builtin_amdgcn_update_dpp(0, __builtin_bit_cast(int, v), CTRL, 0xf, 0xf, false)); }
__device__ __forceinline__ void gla_chain(Frame& F, int l, int chain, int vq) {
    const int b = chain >> 3, h = (chain >> 1) & 3, dir = chain & 1, bh = b * 4 + h;
    const int lane = F.lane, w = F.wave, g = lane >> 4, lr = lane & 15, vt = w & 3, hh = w >> 2;
    LAS unsigned char* L = F.lds;
    constexpr int BUF = 46080;
    bf16* OI = WSP(bf16, dir ? WS_OIB : WS_OIF);
    const unsigned char* gb_base = F.ws + WS_GBLK + (size_t)((bh * 2 + dir) * 68) * GB_BYTES;
    const unsigned char* vt_base = F.ws + WS_VTB + (size_t)(bh * 68) * VT_BYTES + (size_t)vq * 9216;
    f32x4 S[8];
#pragma unroll
    for (int i = 0; i < 8; ++i) S[i] = (f32x4){0.f, 0.f, 0.f, 0.f};
#define CHAIN_CK(step) (dir ? ((step) < 4 ? 3 - (step) : 71 - (step)) : (step))
#define CHAIN_LOAD(step, boff) do { const int ck_ = CHAIN_CK(step); const unsigned char* gsrc = gb_base + (size_t)ck_ * GB_BYTES; const unsigned char* vsrc = vt_base + (size_t)ck_ * VT_BYTES; \
        _Pragma("unroll") for (int i_ = 0; i_ < 6; ++i_) { const int c_ = w + 8 * i_; if (c_ < 45) { const unsigned char* src = (c_ < 36 ? gsrc + 1024 * c_ : vsrc + 1024 * (c_ - 36)) + 16 * lane; \
            __builtin_amdgcn_global_load_lds((const unsigned*)src, (LAS unsigned*)(L + (boff) + 1024 * c_), 16, 0, 0); } } } while (0)
    CHAIN_LOAD(0, 0); CHAIN_LOAD(1, BUF);
    int cb = 0, nb2 = 2 * BUF;
    for (int step = 0; step < 68; ++step) {
        if (step + 1 < 68) { if (w < 5) asm volatile("s_waitcnt vmcnt(6)" ::: "memory"); else asm volatile("s_waitcnt vmcnt(5)" ::: "memory"); }
        else asm volatile("s_waitcnt vmcnt(0)" ::: "memory");
        __builtin_amdgcn_s_barrier(); asm volatile("" ::: "memory");
        const LAS unsigned char* cur = L + cb;
        const int ck = CHAIN_CK(step);
        const int row0 = ck < 4 ? TL + b * CTX + 64 * ck : b * SEQ + 64 * (ck - 4);
        bf16x8v sa[4];
#pragma unroll
        for (int s = 0; s < 4; ++s) { v4u u; u.x = cvt_pk_bf16(S[2 * s][0], S[2 * s][1]); u.y = cvt_pk_bf16(S[2 * s][2], S[2 * s][3]); u.z = cvt_pk_bf16(S[2 * s + 1][0], S[2 * s + 1][1]); u.w = cvt_pk_bf16(S[2 * s + 1][2], S[2 * s + 1][3]);
            sa[s] = __builtin_bit_cast(bf16x8v, u); }
#pragma unroll
        for (int tti = 0; tti < 2; ++tti) { const int tt = 2 * hh + tti; f32x4 acc = (f32x4){0.f, 0.f, 0.f, 0.f};
#pragma unroll
            for (int s = 0; s < 4; ++s) { const bf16x8v bb = *(const LAS bf16x8v*)(cur + GB_QE + (16 * tt + lr) * 272 + (32 * s + 8 * g) * 2); acc = MFMA16(sa[s], bb, acc); }
            *(v2u*)(OI + (size_t)(row0 + 16 * tt + lr) * D + h * 256 + 64 * vq + 16 * vt + 4 * g) = pack4(acc); }
        if (step + 2 < 68) CHAIN_LOAD(step + 2, nb2);
        cb = cb + BUF == 3 * BUF ? 0 : cb + BUF; nb2 = nb2 + BUF == 3 * BUF ? 0 : nb2 + BUF;
        const LAS float* dl = (const LAS float*)(cur + GB_DEC) + 16 * (lr >> 2) + 4 * g + (lr & 3); const float D0 = dl[0], D1 = dl[64];
#define CHAIN_UPD(dt) do { f32x4 acc; const float dsel_ = (dt) < 4 ? D0 : D1; \
            acc[0] = S[dt][0] * dppf<0x150 + 4 * ((dt) & 3) + 0>(dsel_); acc[1] = S[dt][1] * dppf<0x150 + 4 * ((dt) & 3) + 1>(dsel_);        \
            acc[2] = S[dt][2] * dppf<0x150 + 4 * ((dt) & 3) + 2>(dsel_); acc[3] = S[dt][3] * dppf<0x150 + 4 * ((dt) & 3) + 3>(dsel_); \
            _Pragma("unroll") for (int ks = 0; ks < 2; ++ks) { const bf16x8v a = *(const LAS bf16x8v*)(cur + GB_KDT + (16 * (dt) + lr) * 144 + (32 * ks + 8 * g) * 2); \
                const bf16x8v bb = *(const LAS bf16x8v*)(cur + GB_BYTES + (16 * vt + lr) * 144 + (32 * ks + 8 * g) * 2); acc = MFMA16(a, bb, acc); } \
            S[dt] = acc; } while (0)
        CHAIN_UPD(0); CHAIN_UPD(1); CHAIN_UPD(2); CHAIN_UPD(3); CHAIN_UPD(4); CHAIN_UPD(5); CHAIN_UPD(6); CHAIN_UPD(7);
#undef CHAIN_UPD
    }
    asm volatile("s_waitcnt vmcnt(0)" ::: "memory"); __builtin_amdgcn_s_barrier();
#undef CHAIN_CK
#undef CHAIN_LOAD
}
__device__ __forceinline__ void nat_relayout(Frame& F) {
    const bf16* P = WSP(bf16, WS_PROJ); bf16* NK = WSP(bf16, WS_NK); bf16* NVT = WSP(bf16, WS_NVT);
    if (F.bx < 64 && F.G > 64) return;
    const int nlo = F.G > 64 ? 64 : 0; const int gw = (F.bx - nlo) * NWAVES + F.wave, NGW = (F.G - nlo) * NWAVES, lane = F.lane;
    for (int it = gw; it < (T / 8) * 8; it += NGW) {
        const int h = it & 7, blk = it >> 3;
        { const int j = lane >> 3, ch = lane & 7;
          *(v4u*)(NK + ((size_t)h * T + 8 * blk + j) * 64 + 8 * ch) = *(const v4u*)(P + (size_t)(8 * blk + j) * NPROJ + PC_NK + h * 64 + 8 * ch); }
        { const bf16* vp = P + (size_t)(8 * blk) * NPROJ + PC_NV + h * 64 + lane; unsigned x[4];
#pragma unroll
          for (int j2 = 0; j2 < 4; ++j2) x[j2] = (unsigned)vp[(size_t)(2 * j2) * NPROJ] | ((unsigned)vp[(size_t)(2 * j2 + 1) * NPROJ] << 16);
          *(v4u*)(NVT + (((size_t)h * (T / 8) + blk) * 64 + lane) * 8) = (v4u){x[0], x[1], x[2], x[3]}; }
    }
}
typedef short v4i16_t __attribute__((ext_vector_type(4)));
__device__ __forceinline__ v2u vtr64(const LAS unsigned char* p) { return __builtin_bit_cast(v2u, __builtin_amdgcn_ds_read_tr16_b64_v4i16((LAS v4i16_t*)p)); }
constexpr int CW_NATQ = 8192;
__device__ __forceinline__ void nat_wg(Frame& F, int l, volatile LAS unsigned* bcast, bool single) {
    const bf16* P = WSP(bf16, WS_PROJ); const bf16* NK = WSP(bf16, WS_NK); const bf16* NVT = WSP(bf16, WS_NVT); bf16* YN = WSP(bf16, WS_YN);
    unsigned* ctr = (unsigned*)(F.ws + WS_CTL) + CW_NATQ + 64 * l;
    LAS unsigned char* L = F.lds;
    constexpr int L_KB = 0, L_VB = 69120, L_RP = 131584, L_KC = 0, L_VC = 36864, VBP = 976, VCP = 528;
    const int w = F.wave;
    const int NSU = 1024 + (l == DEPTH - 1 ? 0 : 64);
    unsigned nxt_su = 0; if (F.tid == 0) nxt_su = __hip_atomic_fetch_add(ctr, 1u, __ATOMIC_RELAXED, __HIP_MEMORY_SCOPE_AGENT);
    for (;;) {
        int tid = F.tid; asm volatile("" : "+v"(tid));
        const int lane = tid & 63, g = lane >> 4, lr = lane & 15;
        if (tid == 0) { bcast[0] = nxt_su; if (!single && (int)nxt_su < NSU) nxt_su = __hip_atomic_fetch_add(ctr, 1u, __ATOMIC_RELAXED, __HIP_MEMORY_SCOPE_AGENT); else nxt_su = 0x7fffffffu; }
        __syncthreads();
        const int su = (int)bcast[0];
        if (su >= NSU) break;
        const bool lat = su < 1024;
        int b, h, nb = 0, r0 = 0, qrow0;
        if (lat) { const int rg = su & 7; nb = (su >> 3) & 3; h = (su >> 5) & 7; b = su >> 8; r0 = 8 * rg; qrow0 = b * SEQ + (r0 + w) * 64 + 16 * nb; }
        else { const int cu = su - 1024; h = (cu >> 1) & 7; b = cu >> 4; qrow0 = TL + b * CTX + 16 * (8 * (cu & 1) + w); }
        const bf16* NVh = NVT + (size_t)h * (T / 8) * 512;
        const int kr0 = min(max(r0 - 4, 0), 56), nrows = min(max(r0 + 3, 0), 56) + 8 - kr0;
        const int bs = nb == 0 ? 0 : (nb == 1 ? 8 : (nb == 2 ? 24 : 32));
        if (lat) {
            const int nkp = nrows * 256;
            { const int nkb = nrows * 4;
#pragma unroll
              for (int i = 0; i < 8; ++i) { const int blk = w + 8 * i; if (blk < nkb) { const int key = 8 * blk + (lane >> 3); const int grow = b * SEQ + (kr0 + (key >> 5)) * 64 + bs + (key & 31);
                  const bf16* src = P + (size_t)grow * NPROJ + PC_NK + h * 64 + 8 * ((lane & 7) ^ ((key >> 1) & 7));
                  __builtin_amdgcn_global_load_lds((const unsigned*)src, (LAS unsigned*)(L + L_KB + 1024 * blk), 16, 0, 0); } } }
            { const int nkb = nrows * 4;
#pragma unroll
              for (int i = 0; i < 8; ++i) { const int blk = w + 8 * i; if (blk < nkb) { const int key = 8 * blk + (lane >> 3); const int grow = b * SEQ + (kr0 + (key >> 5)) * 64 + bs + (key & 31);
                  const bf16* src = P + (size_t)grow * NPROJ + PC_NV + h * 64 + 8 * ((lane & 7) ^ (((key >> 1) & 3) << 1));
                  __builtin_amdgcn_global_load_lds((const unsigned*)src, (LAS unsigned*)(L + L_VB + 1024 * blk), 16, 0, 0); } } }
            if (tid < 465) ((LAS float*)(L + L_RP))[tid] = F.in[I_RPB][(size_t)(l * 8 + h) * 465 + tid] * 1.4426950408889634f;
        }
        asm volatile("s_waitcnt vmcnt(0)" ::: "memory");
        __syncthreads();
        bf16x8v bq[2];
#pragma unroll
        for (int ks = 0; ks < 2; ++ks) bq[ks] = *(const GAS bf16x8v*)(P + (size_t)(qrow0 + lr) * NPROJ + PC_NQ + h * 64 + 32 * ks + 8 * g);
        v4u kreg[4], vreg[4];
#pragma unroll
        for (int i = 0; i < 4; ++i) { const int p = tid + 512 * i; kreg[i] = *(const GAS v4u*)(P + (size_t)(TL + b * CTX + (p >> 3)) * NPROJ + PC_NK + h * 64 + 8 * (p & 7));
            vreg[i] = *(const GAS v4u*)(P + (size_t)(TL + b * CTX + (p >> 3)) * NPROJ + PC_NV + h * 64 + 8 * (p & 7)); }
        f32x4 O[4];
#pragma unroll
        for (int dt = 0; dt < 4; ++dt) O[dt] = (f32x4){0.f, 0.f, 0.f, 0.f};
        float m = -1.0e30f, lsum = 0.f;
        const int r = r0 + w, rs = min(max(r - 4, 0), 56), lb = rs - kr0;
        const int c = 16 * nb + lr, cs = min(max(c - 8, 0), 48);
        constexpr float QS = 0.125f * 1.4426950408889634f;
        bool vm[2][4];
#pragma unroll
        for (int k1 = 0; k1 < 2; ++k1)
#pragma unroll
            for (int e = 0; e < 4; ++e) vm[k1][e] = (unsigned)(bs + 16 * k1 + 4 * g + e - cs) < 16u;
        const int vrow = (4 * g + (lr >> 2)) * 128 + 8 * (lr & 1), vx = ((2 * g + (lr >> 3)) & 3) << 1;
        const LAS float* Rb = (const LAS float*)(L + L_RP) + (rs - r + 7) * 31 + 15 - c + bs + 4 * g;
#pragma unroll
        for (int qt = 0; qt < 4; ++qt) {
            const int half = qt >> 1, sub = qt & 1;
            if (half == 0 && !lat) continue;
            if (qt == 2) {
                __syncthreads();
#pragma unroll
                for (int i = 0; i < 4; ++i) { const int p = tid + 512 * i; *(LAS v4u*)(L + L_KC + (p >> 3) * 144 + 16 * (p & 7)) = kreg[i]; *(LAS v4u*)(L + L_VC + (p >> 3) * 128 + 16 * ((p & 7) ^ ((((p >> 3) >> 1) & 3) << 1))) = vreg[i]; }
                __syncthreads();
            }
            f32x4 s[8];
#pragma unroll
            for (int k8 = 0; k8 < 8; ++k8) { const int kt = 8 * sub + k8;
                f32x4 acc = (f32x4){0.f, 0.f, 0.f, 0.f};
                __builtin_amdgcn_s_setprio(1);
#pragma unroll
                for (int ks = 0; ks < 2; ++ks) {
                    const LAS unsigned char* kp = half == 0 ? L + L_KB + (32 * (lb + (kt >> 1)) + 16 * (kt & 1) + lr) * 128 + (((4 * ks + g) ^ (lr >> 1)) * 16) : L + L_KC + (16 * kt + lr) * 144 + (32 * ks + 8 * g) * 2;
                    const bf16x8v ak = *(const LAS bf16x8v*)kp; acc = MFMA16(ak, bq[ks], acc); }
                __builtin_amdgcn_s_setprio(0);
                if (half == 0) {
#pragma unroll
                    for (int e = 0; e < 4; ++e) acc[e] = vm[kt & 1][e] ? __builtin_fmaf(acc[e], QS, Rb[31 * (kt >> 1) + 16 * (kt & 1) + e]) : -1.0e30f; }
                s[k8] = acc;
            }
            float mx = -1.0e30f;
#pragma unroll
            for (int k8 = 0; k8 < 8; ++k8) mx = fmaxf(fmaxf(fmaxf(mx, s[k8][0]), fmaxf(s[k8][1], s[k8][2])), s[k8][3]);
            if (half == 1) mx *= QS;
            mx = fmaxf(mx, __shfl_xor(mx, 16)); mx = fmaxf(mx, __shfl_xor(mx, 32));
            const float m2 = fmaxf(m, mx), sc = __builtin_amdgcn_exp2f(m - m2); m = m2; lsum *= sc;
#pragma unroll
            for (int dt = 0; dt < 4; ++dt) O[dt] = O[dt] * sc;
            float ps = 0.f;
#pragma unroll
            for (int k8 = 0; k8 < 8; ++k8)
#pragma unroll
                for (int e = 0; e < 4; ++e) { const float p = __builtin_amdgcn_exp2f(half == 0 ? s[k8][e] - m2 : __builtin_fmaf(s[k8][e], QS, -m2)); s[k8][e] = p; ps += p; }
            lsum += ps;
#pragma unroll
            for (int k4 = 0; k4 < 4; ++k4) {
                const int k2 = 4 * sub + k4;
                v4u pu; pu.x = cvt_pk_bf16(s[2 * k4][0], s[2 * k4][1]); pu.y = cvt_pk_bf16(s[2 * k4][2], s[2 * k4][3]); pu.z = cvt_pk_bf16(s[2 * k4 + 1][0], s[2 * k4 + 1][1]); pu.w = cvt_pk_bf16(s[2 * k4 + 1][2], s[2 * k4 + 1][3]);
                const bf16x8v pb = __builtin_bit_cast(bf16x8v, pu);
                __builtin_amdgcn_s_setprio(1);
                const LAS unsigned char* vp = (half == 0 ? L + L_VB + (32 * (lb + k2)) * 128 : L + L_VC + (32 * k2) * 128) + vrow;
#pragma unroll
                for (int dt = 0; dt < 4; ++dt) {
                    const LAS unsigned char* va_p = vp + 16 * ((2 * dt + (lr >> 1 & 1)) ^ vx);
                    const v2u va = vtr64(va_p), vb = vtr64(va_p + 16 * 128);
                    const bf16x8v av = __builtin_bit_cast(bf16x8v, (v4u){va.x, va.y, vb.x, vb.y});
                    O[dt] = MFMA16(av, pb, O[dt]);
                }
                __builtin_amdgcn_s_setprio(0);
            }
        }
        lsum += __shfl_xor(lsum, 16); lsum += __shfl_xor(lsum, 32);
        const float inv = 1.0f / lsum;
#pragma unroll
        for (int dt = 0; dt < 4; ++dt) *(v2u*)(YN + (size_t)(qrow0 + lr) * 512 + h * 64 + 16 * dt + 4 * g) = pack4(O[dt] * inv);
    }
}

constexpr int NPL = 11, NPHASES = 2 + DEPTH * NPL;
struct Args { const float* in[N_IN]; float* out; unsigned char* ws; int ph_lo, ph_hi; };
static_assert(sizeof(Args) == N_IN * 8 + 8 + 8 + 8, "Args has no padding");
__global__ void __launch_bounds__(NWAVES * 64, 2) fwd_kernel(Args args) {
    extern __shared__ __attribute__((aligned(16))) unsigned char lds_raw[];
    Frame F;
    F.lds = (LAS unsigned char*)lds_raw;
    F.tid = otid(); F.lane = F.tid & 63; F.wave = __builtin_amdgcn_readfirstlane(F.tid >> 6);
    F.G = gridDim.x; F.bx = blockIdx.x; F.ws = args.ws; F.out = args.out;
    { KIN inp = (KIN)__builtin_amdgcn_kernarg_segment_ptr(); asm volatile("" : "+s"(inp)); F.in = inp; }
    volatile LAS unsigned* MISC = (volatile LAS unsigned*)(F.lds + MISC_OFF);
    for (int u = F.tid; u < (LDS_BYTES - LDSCTL_OFF) / 4; u += NWAVES * 64) ((LAS unsigned*)(F.lds + LDSCTL_OFF))[u] = 0u;
    __syncthreads();
    XcdBarrier bar; bar.bar = (unsigned*)(args.ws + WS_CTL) + CW_BAR; bar.x = 0; bar.st = nullptr;
    if (!MK_MULTI) bar = xcd_barrier_post((unsigned*)(args.ws + WS_CTL) + CW_BAR, MISC + 8);
    const int lo = args.ph_lo, hi = args.ph_hi;
#define IN(k) (lo <= (k) && (k) < hi)
#define RETID() do { F.tid = otid(); F.lane = F.tid & 63; F.wave = __builtin_amdgcn_readfirstlane(F.tid >> 6); asm volatile("" : "+s"(F.ws), "+s"(F.out), "+s"(F.in)); } while (0)
#define SEAM(k) do { if (!MK_MULTI && (k) + 1 < hi) xcd_barrier<false>(bar); } while (0)
#define SEAM0() do { if (!MK_MULTI && 1 < hi) xcd_barrier<true>(bar); } while (0)
    using namespace pg8;
    LAS unsigned char* ring = F.lds;

#ifndef NO_G0
    if (IN(0)) { phase_g0(F); SEAM0(); }
#endif
    if (SITE_THIN && IN(1)) { phase_g1(F); SEAM(1); }
    for (int l = 0; l < DEPTH; ++l) {
        const int base = 2 + l * NPL; const bool moe = (l & 1) != 0;
        if (SITE_PROJ && IN(base + 0)) { RETID();
            Gemm g{WSP(bf16, WS_H), WSP(bf16, WS_WIN) + (size_t)l * NPROJ * D, T, NPROJ, D}; StaticOrder S; S.init(T, NPROJ, F.G, F.bx);
            EpiProj E{WSP(bf16, WS_PROJ), NPROJ, WSP(bf16, WS_NVT), -1000, T / 8};
            gemm_phase<EpiProj, StaticOrder, PG8_ALIGN, PG8_SP2>(ring, g, S, E);
            SEAM(base + 0);
        }
        if (IN(base + 1)) { RETID();
#ifndef NO_PREP
            gla_prep(F, l);
#endif
#ifndef NO_NATWG
            if (F.bx >= 64) nat_wg(F, l, MISC + 16, true);
#endif
            SEAM(base + 1); }
        if (IN(base + 2)) { RETID();
#ifndef NO_CHAIN
            if (F.bx < 128) gla_chain(F, l, F.bx & 31, F.bx >> 5);
#endif
#ifndef NO_NATWG
            nat_wg(F, l, MISC + 16, false);
#endif
            SEAM(base + 2);
        }
        if (SITE_THIN && IN(base + 3)) { RETID(); phase_gla_out(F, l); SEAM(base + 3); }
        if (SITE_BR && IN(base + 4)) { RETID();
            const int nctx1 = l == DEPTH - 1 ? 0 : 32, nctx2 = l == DEPTH - 1 ? 0 : 16;
            { Gemm g{WSP(bf16, WS_YG), WSP(bf16, WS_WBG) + (size_t)l * D * D, TROWS(l), D, D}; BranchOrder S; S.init(TL, F.G, F.bx, 0, nctx1, 2, 512);
              EpiGateBr<false, false> E{WSP(bf16, WS_MB), D, WSP(bf16, WS_PROJ) + PC_GA, NPROJ, WSP(bf16, WS_MB3)};
              gemm_phase<EpiGateBr<false, false>, BranchOrder, PG8_ALIGN, PG8_SP2>(ring, g, S, E); }
            VM_WAIT(); __syncthreads();
            { Gemm g{WSP(bf16, WS_YN), WSP(bf16, WS_WBN) + (size_t)l * D * 512, TROWS(l), D, 512}; BranchOrder S; S.init(TL, F.G, F.bx, 32, nctx2, 1, 512);
              EpiGateBr<true, true> E{WSP(bf16, WS_MB), D, WSP(bf16, WS_PROJ) + PC_GB, NPROJ, WSP(bf16, WS_MB2)};
              gemm_phase<EpiGateBr<true, true>, BranchOrder, PG8_ALIGN, PG8_SP2>(ring, g, S, E); }
            SEAM(base + 4);
        }
        if (SITE_OUT && IN(base + 5)) { RETID();
            Gemm g{WSP(bf16, WS_MB), WSP(bf16, WS_WO) + (size_t)l * D * D, TROWS(l), D, D};
            { CtxSplit3Order S; S.init(TL, F.G, F.bx, (long)(WS_MB2 - WS_MB) - (long)TL * D * 2, (long)(WS_MB3 - WS_MB) - (long)TL * D * 2, l == DEPTH - 1 ? 0 : 192);
              EpiStoreSplit3 E{WSP(bf16, WS_Y), D, WSP(bf16, WS_YC)}; gemm_phase<EpiStoreSplit3, CtxSplit3Order, PG8_ALIGN, PG8_SP2>(ring, g, S, E); }
            SEAM(base + 5);
        }
        if (SITE_THIN && IN(base + 6)) { RETID(); phase_post_mix(F, l); SEAM(base + 6); }
        if (SITE_THIN && moe && IN(base + 7)) { RETID(); phase_moe_gather(F, l); SEAM(base + 7); }
        if (SITE_UP && IN(base + 8)) { RETID();
            EpiSwiGLU8 E{WSP(unsigned char, WS_HID), DFF};
            { int cnt[8] = {T, 0, 0, 0, 0, 0, 0, 0}; MoeOrder S; Gemm g;
              if (moe) { moe_counts(F, l >> 1, cnt); S.init(cnt, 28, (long)7168 * D * 2, F.G, F.bx); g = Gemm{WSP(bf16, WS_XG), WSP(bf16, WS_W13) + (size_t)(2 + (l >> 1) * 8) * 7168 * D, 0, 7168, D / 2}; }
              else { S.init(cnt, 28, 0L, F.G, F.bx); g = Gemm{WSP(bf16, WS_H), WSP(bf16, WS_W13) + (size_t)(l >> 1) * 7168 * D, T, 7168, D / 2}; }
              gemm_phase<EpiSwiGLU8, MoeOrder, PG8_ALIGN, PG8_SP2, true>(ring, g, S, E, 122, 127); }
            SEAM(base + 8);
        }
        if (SITE_DOWN && IN(base + 9)) { RETID();
            if (moe) { int cnt[8]; moe_counts(F, l >> 1, cnt); const int st = moe_split_tile(cnt, F.G); MoeOrder S; S.init(cnt, 4, (long)D * DFF * 2, F.G, F.bx, st, 7, 256);
                Gemm g{WSP(bf16, WS_HID), WSP(bf16, WS_W2) + (size_t)(2 + (l >> 1) * 8) * D * DFF, 0, D, DFF / 2};
                EpiMoeDown E{WSP(bf16, WS_FS), D, WSP(bf16, WS_XG), 512, st, (size_t)MOE_SL_ROWS * D};
                gemm_phase<EpiMoeDown, MoeOrder, PG8_ALIGN, PG8_SP2, true>(ring, g, S, E, 122, 127); }
#if DENSE_FP8
            else { Gemm g{WSP(bf16, WS_HID), WSP(bf16, WS_W2) + (size_t)(l >> 1) * D * DFF, T, D, DFF / 2}; CtxSplitOrder S; S.init(TL, DFF / 2, 256, F.G, F.bx);
                EpiStoreSplit E2{WSP(bf16, WS_FS), D, WSP(bf16, WS_FC), 512}; gemm_phase<EpiStoreSplit, CtxSplitOrder, PG8_ALIGN, PG8_SP2, true>(ring, g, S, E2, 122, 127); }
#else
            else { Gemm g{WSP(bf16, WS_HID), WSP(bf16, WS_W2) + (size_t)(l >> 1) * D * DFF, T, D, DFF}; CtxSplitOrder S; S.init(TL, DFF, 512, F.G, F.bx);
                EpiStoreSplit E2{WSP(bf16, WS_FS), D, WSP(bf16, WS_FC), 1024}; gemm_phase<EpiStoreSplit, CtxSplitOrder, PG8_ALIGN, PG8_SP2>(ring, g, S, E2); }
#endif
            SEAM(base + 9);
        }
        if (SITE_THIN && IN(base + 10)) { RETID(); phase_post_ffn(F, l); SEAM(base + 10); }
    }
#undef IN
#undef SEAM
}

static bool phase_applicable(int k) {
    if (k < 2) return true;
    const int l = (k - 2) / NPL, p = (k - 2) % NPL;
    if (p == 7) return (l & 1) != 0;
    return true;
}
extern "C" void kernel_launch(void* const* d_in, const int* in_sizes, int n_in, void* d_out, int out_size, void* d_ws, size_t ws_size, hipStream_t stream) {
    static int grid = 0;
    if (grid == 0) {
        if (n_in != N_IN || out_size != TL * D || ws_size < WS_END) { fprintf(stderr, "kernel_launch: unexpected shapes (n_in %d, out %d, ws %zu < %zu)\n", n_in, out_size, ws_size, (size_t)WS_END); grid = -1; return; }
        int dev = 0, cus = 0, per_cu = 0;
        if (hipGetDevice(&dev) != hipSuccess || hipDeviceGetAttribute(&cus, hipDeviceAttributeMultiprocessorCount, dev) != hipSuccess) { grid = -1; return; }
        if (hipFuncSetAttribute((const void*)fwd_kernel, hipFuncAttributeMaxDynamicSharedMemorySize, LDS_BYTES) != hipSuccess) { fprintf(stderr, "kernel_launch: hipFuncSetAttribute failed\n"); grid = -1; return; }
        if (hipOccupancyMaxActiveBlocksPerMultiprocessor(&per_cu, (const void*)fwd_kernel, NWAVES * 64, LDS_BYTES) != hipSuccess || per_cu < 1)
            fprintf(stderr, "kernel_launch: occupancy query reports %d blocks per CU\n", per_cu);
        (void)hipGetLastError();
        grid = cus;
    }
    if (grid < 0) return;
    if (hipMemsetAsync((char*)d_ws + WS_CTL, 0, CTL_ZERO_BYTES, stream) != hipSuccess) { fprintf(stderr, "kernel_launch: memset failed\n"); return; }
    Args a{};
    for (int i = 0; i < N_IN; ++i) a.in[i] = (const float*)d_in[i];
    a.out = (float*)d_out; a.ws = (unsigned char*)d_ws;
#if MK_MULTI
    for (int k = 0; k < NPHASES; ++k) { if (!phase_applicable(k)) continue; a.ph_lo = k; a.ph_hi = k + 1;
        hipLaunchKernelGGL(fwd_kernel, dim3(grid), dim3(NWAVES * 64), LDS_BYTES, stream, a); }
#else
    a.ph_lo = 0; a.ph_hi = NPHASES;
    hipLaunchKernelGGL(fwd_kernel, dim3(grid), dim3(NWAVES * 64), LDS_BYTES, stream, a);
#endif
    const hipError_t le = hipPeekAtLastError();
    if (le != hipSuccess) fprintf(stderr, "kernel_launch: launch failed: %s\n", hipGetErrorName(le));
}
```
